# Optimizing an MI355X kernel written in HIP

```python
import jax, jax.numpy as jnp
from jax import lax
import numpy as np

D_MODEL = 1024
BATCH = 8
SEQ = 2048
DEPTH = 1

ATT_HEADS = 8
ATT_KV_HEADS = 2
ATT_GROUP = ATT_HEADS // ATT_KV_HEADS
ATT_HEAD_DIM = 64
WINDOW = 128
ATT_BLOCK = WINDOW
ROPE_THETA = 500000.0
ROPE_DIMS = ATT_HEAD_DIM // 4

RET_HEADS = 8
RET_QK_DIM = 64
RET_V_DIM = 128
RET_CHUNK = 128
RET_THETA = 10000.0

ATT_Q = ATT_HEADS * ATT_HEAD_DIM
ATT_KV = ATT_KV_HEADS * ATT_HEAD_DIM
RET_QK = RET_HEADS * RET_QK_DIM
RET_V = RET_HEADS * RET_V_DIM
IN_SIZES = (ATT_Q, ATT_KV, ATT_KV, RET_QK, RET_QK, RET_V, RET_V, D_MODEL, D_MODEL)
IN_WIDTH = 5888

PEER_HEADS = 8
N_KEYS = 128
N_EXPERTS = N_KEYS * N_KEYS
PEER_QUERY_DIM = 256
PEER_HALF = PEER_QUERY_DIM // 2
PEER_TOPK = 16
PEER_TOKEN_BLOCK = 128

EPS = 1e-6
F32 = jnp.float32

kernel_name = 'hybrid_swa_sink_retention_peer_block'


def rms_norm(x, gain):
    xf = x.astype(F32)
    y = xf * lax.rsqrt(jnp.mean(xf * xf, axis=-1, keepdims=True) + EPS)
    return (y * gain.astype(F32)).astype(x.dtype)


def split_columns(t, sizes):
    outs, start = [], 0
    for s in sizes:
        outs.append(t[..., start:start + s])
        start += s
    return outs


def apply_rotary(x, positions, rot_dims, theta):
    half = rot_dims // 2
    inv_freq = theta ** (-jnp.arange(half, dtype=F32) / half)
    ang = positions.astype(F32)[:, None] * inv_freq[None, :]
    cos = jnp.cos(ang)[:, None, :]
    sin = jnp.sin(ang)[:, None, :]
    xf = x.astype(F32)
    x1 = xf[..., :half]
    x2 = xf[..., half:rot_dims]
    out = jnp.concatenate([x1 * cos - x2 * sin, x2 * cos + x1 * sin, xf[..., rot_dims:]], axis=-1)
    return out.astype(x.dtype)


def sliding_window_attention(q, k, v, sinks):
    B, S = q.shape[0], q.shape[1]
    nb = S // ATT_BLOCK
    qb = q.reshape(B, nb, ATT_BLOCK, ATT_KV_HEADS, ATT_GROUP, ATT_HEAD_DIM)

    def with_previous_block(t):
        tb = t.reshape(B, nb, ATT_BLOCK, ATT_KV_HEADS, ATT_HEAD_DIM)
        prev = jnp.pad(tb[:, :-1], ((0, 0), (1, 0), (0, 0), (0, 0), (0, 0)))
        return jnp.concatenate([prev, tb], axis=2)

    kb = with_previous_block(k)
    vb = with_previous_block(v)
    s = jnp.einsum('bnqhgd,bnkhd->bnhgqk', qb, kb, preferred_element_type=F32)
    s = s * (ATT_HEAD_DIM ** -0.5)
    qi = jnp.arange(ATT_BLOCK)[:, None] + ATT_BLOCK
    kj = jnp.arange(2 * ATT_BLOCK)[None, :]
    diff = qi - kj
    band = (diff >= 0) & (diff < WINDOW)
    key_pos = jnp.arange(nb)[:, None] * ATT_BLOCK + kj - ATT_BLOCK
    mask = band[None] & (key_pos >= 0)[:, None, :]
    s = jnp.where(mask[None, :, None, None], s, -jnp.inf)
    sink = sinks.astype(F32).reshape(ATT_KV_HEADS, ATT_GROUP)[None, None, :, :, None, None]
    m = jnp.maximum(jnp.max(s, axis=-1, keepdims=True), sink)
    p = jnp.exp(s - m)
    p = p / (jnp.sum(p, axis=-1, keepdims=True) + jnp.exp(sink - m))
    o = jnp.einsum('bnhgqk,bnkhd->bnqhgd', p.astype(v.dtype), vb)
    return o.reshape(B, S, ATT_Q)


def chunkwise_retention(q, k, v):
    B, S = q.shape[0], q.shape[1]
    C = RET_CHUNK
    nc = S // C
    qc = q.astype(F32).reshape(B, nc, C, RET_HEADS, RET_QK_DIM)
    kc = k.astype(F32).reshape(B, nc, C, RET_HEADS, RET_QK_DIM)
    vc = v.astype(F32).reshape(B, nc, C, RET_HEADS, RET_V_DIM)
    log_gamma = jnp.log1p(-jnp.exp2(-5.0 - jnp.arange(RET_HEADS, dtype=F32)))
    idx = jnp.arange(C, dtype=F32)
    diff = idx[:, None] - idx[None, :]
    decay_inner = jnp.where(diff[None] >= 0,
                            jnp.exp(log_gamma[:, None, None] * jnp.maximum(diff, 0.0)[None]), 0.0)
    scores = jnp.einsum('bnihd,bnjhd->bnhij', qc, kc) * decay_inner[None, None]
    o_inner = jnp.einsum('bnhij,bnjhe->bnihe', scores, vc)
    w_key = jnp.exp(log_gamma[:, None] * (C - 1.0 - idx)[None, :])
    kv = jnp.einsum('bnjhd,hj,bnjhe->bnhde', kc, w_key, vc)
    chunk_decay = jnp.exp(log_gamma * C)[None, :, None, None]

    def step(state, kv_n):
        return state * chunk_decay + kv_n, state

    init = jnp.zeros((B, RET_HEADS, RET_QK_DIM, RET_V_DIM), F32)
    _, states = lax.scan(step, init, jnp.moveaxis(kv, 1, 0))
    states = jnp.moveaxis(states, 0, 1)
    w_query = jnp.exp(log_gamma[:, None] * (idx + 1.0)[None, :])
    o_cross = jnp.einsum('bnihd,hi,bnhde->bnihe', qc, w_query, states)
    return (o_inner + o_cross).reshape(B, S, RET_HEADS, RET_V_DIM)


def hybrid_mixer(hn, positions, w_in, att_sinks, w_att_branch, w_ret_branch, w_out):
    B, S = hn.shape[0], hn.shape[1]
    proj = hn @ w_in
    q_a, k_a, v_a, q_r, k_r, v_r, g_r, gate_a, gate_r = split_columns(proj, IN_SIZES)
    q_a = apply_rotary(q_a.reshape(B, S, ATT_HEADS, ATT_HEAD_DIM), positions, ROPE_DIMS, ROPE_THETA)
    k_a = apply_rotary(k_a.reshape(B, S, ATT_KV_HEADS, ATT_HEAD_DIM), positions, ROPE_DIMS, ROPE_THETA)
    v_a = v_a.reshape(B, S, ATT_KV_HEADS, ATT_HEAD_DIM)
    att = sliding_window_attention(q_a, k_a, v_a, att_sinks)
    q_r = apply_rotary(q_r.reshape(B, S, RET_HEADS, RET_QK_DIM), positions, RET_QK_DIM, RET_THETA)
    k_r = apply_rotary(k_r.reshape(B, S, RET_HEADS, RET_QK_DIM), positions, RET_QK_DIM, RET_THETA) * (RET_QK_DIM ** -0.5)
    ret = chunkwise_retention(q_r, k_r, v_r.reshape(B, S, RET_HEADS, RET_V_DIM))
    ret = ret * lax.rsqrt(jnp.mean(ret * ret, axis=-1, keepdims=True) + EPS)
    ret = jax.nn.silu(g_r) * ret.reshape(B, S, RET_V).astype(hn.dtype)
    merged = jax.nn.sigmoid(gate_a) * (att @ w_att_branch) + jax.nn.sigmoid(gate_r) * (ret @ w_ret_branch)
    return merged @ w_out


def peer_ffn(hn, w_query, sub_keys_1, sub_keys_2, expert_u, expert_v):
    B, S, D = hn.shape
    T = B * S
    hf = hn.reshape(T, D)
    q = (hf @ w_query).reshape(T, PEER_HEADS, 2, PEER_HALF)
    s1 = jnp.einsum('thc,kc->thk', q[:, :, 0], sub_keys_1, preferred_element_type=F32)
    s2 = jnp.einsum('thc,kc->thk', q[:, :, 1], sub_keys_2, preferred_element_type=F32)
    v1, i1 = lax.top_k(s1, PEER_TOPK)
    v2, i2 = lax.top_k(s2, PEER_TOPK)
    cand_score = (v1[..., :, None] + v2[..., None, :]).reshape(T, PEER_HEADS, PEER_TOPK * PEER_TOPK)
    cand_index = (i1[..., :, None] * N_KEYS + i2[..., None, :]).reshape(T, PEER_HEADS, PEER_TOPK * PEER_TOPK)
    top_score, pick = lax.top_k(cand_score, PEER_TOPK)
    expert_index = jnp.take_along_axis(cand_index, pick, axis=-1)
    gate = jax.nn.softmax(top_score, axis=-1)
    nblk = T // PEER_TOKEN_BLOCK

    def block_fn(args):
        xb, ib, gb = args
        u = expert_u[ib]
        a = jnp.einsum('td,thkd->thk', xb, u, preferred_element_type=F32)
        coef = gb * jax.nn.gelu(a, approximate=False)
        vv = expert_v[ib]
        return jnp.einsum('thk,thkd->td', coef.astype(vv.dtype), vv)

    out = lax.map(block_fn, (hf.reshape(nblk, PEER_TOKEN_BLOCK, D),
                             expert_index.reshape(nblk, PEER_TOKEN_BLOCK, PEER_HEADS, PEER_TOPK),
                             gate.reshape(nblk, PEER_TOKEN_BLOCK, PEER_HEADS, PEER_TOPK)))
    return out.reshape(B, S, D).astype(hn.dtype)


def setup_inputs(seed: int = 0) -> dict:
    key = jax.random.key(seed)
    ks = jax.random.split(key, 16)

    def normal(k, shape, scale):
        return jax.random.normal(k, shape, F32) * scale

    L = DEPTH
    return {
        'x': normal(ks[0], (BATCH, SEQ, D_MODEL), 1.0),
        'norm_mix': 1.0 + normal(ks[1], (L, D_MODEL), 0.01),
        'w_in': normal(ks[2], (L, D_MODEL, IN_WIDTH), D_MODEL ** -0.5),
        'att_sinks': normal(ks[3], (L, ATT_HEADS), 0.5),
        'w_att_branch': normal(ks[4], (L, ATT_Q, D_MODEL), ATT_Q ** -0.5),
        'w_ret_branch': normal(ks[5], (L, RET_V, D_MODEL), RET_V ** -0.5),
        'w_out': normal(ks[6], (L, D_MODEL, D_MODEL), D_MODEL ** -0.5),
        'norm_ffn': 1.0 + normal(ks[7], (L, D_MODEL), 0.01),
        'peer_w_query': normal(ks[8], (L, D_MODEL, PEER_HEADS * PEER_QUERY_DIM), D_MODEL ** -0.5),
        'peer_sub_keys_1': normal(ks[9], (L, N_KEYS, PEER_HALF), PEER_HALF ** -0.5),
        'peer_sub_keys_2': normal(ks[10], (L, N_KEYS, PEER_HALF), PEER_HALF ** -0.5),
        'peer_u': normal(ks[11], (L, N_EXPERTS, D_MODEL), D_MODEL ** -0.5),
        'peer_v': normal(ks[12], (L, N_EXPERTS, D_MODEL), 0.5),
        'norm_final': 1.0 + normal(ks[13], (D_MODEL,), 0.01),
    }


def reference(x, norm_mix, w_in, att_sinks, w_att_branch, w_ret_branch, w_out, norm_ffn,
              peer_w_query, peer_sub_keys_1, peer_sub_keys_2, peer_u, peer_v, norm_final):
    positions = jnp.arange(x.shape[1], dtype=jnp.int32)
    h = x
    for layer in range(DEPTH):
        h = h + hybrid_mixer(rms_norm(h, norm_mix[layer]), positions, w_in[layer], att_sinks[layer],
                             w_att_branch[layer], w_ret_branch[layer], w_out[layer])
        h = h + peer_ffn(rms_norm(h, norm_ffn[layer]), peer_w_query[layer], peer_sub_keys_1[layer],
                         peer_sub_keys_2[layer], peer_u[layer], peer_v[layer])
    return rms_norm(h, norm_final)
```

```cpp
#include <hip/hip_runtime.h>
#include <cstdint>
#include <cstdio>

constexpr int BATCH = 8, SEQ = 2048, DM = 1024, T = BATCH * SEQ;
constexpr int INW = 5888;
constexpr float EPS = 1e-6f;
constexpr size_t MiB = 1u << 20;
constexpr size_t WS_TAB = 1 * MiB;
constexpr size_t WS_QA = 24 * MiB, WS_KVA = 40 * MiB, WS_QR = 48 * MiB, WS_KR = 64 * MiB, WS_VR = 80 * MiB, WS_GR = 112 * MiB, WS_GA = 144 * MiB, WS_GT = 176 * MiB;
constexpr size_t WS_MERGED = WS_VR, WS_HN2 = WS_GR, WS_PQ = WS_GA, WS_IDX = WS_KR, WS_GATE = WS_KR + 8 * MiB;
constexpr size_t DO_HN = 0, DO_RET = 0, DO_ATT = 32 * MiB;

typedef uint16_t bf16;
__device__ __forceinline__ bf16 f2bf(float f) { unsigned u = __builtin_bit_cast(unsigned, f); return (bf16)((u + 0x7fffu + ((u >> 16) & 1u)) >> 16); }
__device__ __forceinline__ float bf2f(bf16 h) { return __builtin_bit_cast(float, (unsigned)h << 16); }
__device__ __forceinline__ float wave_sum(float v) {
#pragma unroll
    for (int o = 1; o < 64; o <<= 1) v += __shfl_xor(v, o);
    return v;
}

__global__ void k_tables(float* tab) {
    const int i = blockIdx.x * blockDim.x + threadIdx.x;
    if (i >= 2048 * 40) return;
    const int pos = i / 40, f = i % 40;
    float* cosA = tab, *sinA = tab + 2048 * 8, *cosR = tab + 2048 * 16, *sinR = tab + 2048 * 16 + 2048 * 32;
    if (f < 8) {
        const float inv = (float)pow(500000.0, -(double)f / 8.0);
        const float ang = (float)pos * inv;
        cosA[pos * 8 + f] = (float)cos((double)ang); sinA[pos * 8 + f] = (float)sin((double)ang);
    } else {
        const int g = f - 8;
        const float inv = (float)pow(10000.0, -(double)g / 32.0);
        const float ang = (float)pos * inv;
        cosR[pos * 32 + g] = (float)cos((double)ang); sinR[pos * 32 + g] = (float)sin((double)ang);
    }
}

__global__ __launch_bounds__(256) void k_rms_rows(const float* x, const float* gain, bf16* out) {
    const int row = blockIdx.x * 4 + (threadIdx.x >> 6), lane = threadIdx.x & 63;
    const float4* xr = (const float4*)(x + (size_t)row * DM);
    float4 v[4]; float s = 0.f;
#pragma unroll
    for (int j = 0; j < 4; ++j) { v[j] = xr[lane + 64 * j]; s += v[j].x * v[j].x + v[j].y * v[j].y + v[j].z * v[j].z + v[j].w * v[j].w; }
    const float rstd = 1.0f / sqrtf(wave_sum(s) * (1.0f / DM) + EPS);
#pragma unroll
    for (int j = 0; j < 4; ++j) {
        const float4 g = ((const float4*)gain)[lane + 64 * j];
        ushort4 o; o.x = f2bf(v[j].x * rstd * g.x); o.y = f2bf(v[j].y * rstd * g.y); o.z = f2bf(v[j].z * rstd * g.z); o.w = f2bf(v[j].w * rstd * g.w);
        ((ushort4*)(out + (size_t)row * DM))[lane + 64 * j] = o;
    }
}

struct EpiProj {
    unsigned char* ws;
    __device__ __forceinline__ void operator()(int r, int c, float v) const {
        bf16* dst; int ld, cc;
        if (c < 512) { dst = (bf16*)(ws + WS_QA); ld = 512; cc = c; }
        else if (c < 768) { dst = (bf16*)(ws + WS_KVA); ld = 256; cc = c - 512; }
        else if (c < 1280) { dst = (bf16*)(ws + WS_QR); ld = 512; cc = c - 768; }
        else if (c < 1792) { dst = (bf16*)(ws + WS_KR); ld = 512; cc = c - 1280; }
        else if (c < 2816) { dst = (bf16*)(ws + WS_VR); ld = 1024; cc = c - 1792; }
        else if (c < 3840) { dst = (bf16*)(ws + WS_GR); ld = 1024; cc = c - 2816; }
        else if (c < 4864) { dst = (bf16*)(ws + WS_GA); ld = 1024; cc = c - 3840; }
        else { dst = (bf16*)(ws + WS_GT); ld = 1024; cc = c - 4864; }
        dst[(size_t)r * ld + cc] = f2bf(v);
    }
};
struct EpiResid {
    const float* x; float* h;
    __device__ __forceinline__ void operator()(int r, int c, float v) const { h[(size_t)r * DM + c] = x[(size_t)r * DM + c] + v; }
};
struct EpiBf16 {
    bf16* o; int ld;
    __device__ __forceinline__ void operator()(int r, int c, float v) const { o[(size_t)r * ld + c] = f2bf(v); }
};

template <class Epi>
__global__ __launch_bounds__(256) void k_gemm(const bf16* A, int lda, const float* B, int ldb, int K, Epi epi) {
    __shared__ float As[16][68];
    __shared__ float Bs[16][68];
    const int tid = threadIdx.x, tx = tid & 15, ty = tid >> 4;
    const int m0 = blockIdx.y * 64, n0 = blockIdx.x * 64;
    float acc[4][4];
#pragma unroll
    for (int i = 0; i < 4; ++i)
#pragma unroll
        for (int j = 0; j < 4; ++j) acc[i][j] = 0.f;
    for (int k0 = 0; k0 < K; k0 += 16) {
        { const int r = tid >> 2, kk = (tid & 3) * 4; const ushort4 v = *(const ushort4*)(A + (size_t)(m0 + r) * lda + k0 + kk);
          As[kk + 0][r] = bf2f(v.x); As[kk + 1][r] = bf2f(v.y); As[kk + 2][r] = bf2f(v.z); As[kk + 3][r] = bf2f(v.w); }
        { const int kk = tid >> 4, nn = (tid & 15) * 4; const float4 v = *(const float4*)(B + (size_t)(k0 + kk) * ldb + n0 + nn);
          Bs[kk][nn + 0] = v.x; Bs[kk][nn + 1] = v.y; Bs[kk][nn + 2] = v.z; Bs[kk][nn + 3] = v.w; }
        __syncthreads();
#pragma unroll
        for (int kk = 0; kk < 16; ++kk) {
            float a[4], b[4];
#pragma unroll
            for (int i = 0; i < 4; ++i) { a[i] = As[kk][ty * 4 + i]; b[i] = Bs[kk][tx * 4 + i]; }
#pragma unroll
            for (int i = 0; i < 4; ++i)
#pragma unroll
                for (int j = 0; j < 4; ++j) acc[i][j] += a[i] * b[j];
        }
        __syncthreads();
    }
#pragma unroll
    for (int i = 0; i < 4; ++i)
#pragma unroll
        for (int j = 0; j < 4; ++j) epi(m0 + ty * 4 + i, n0 + tx * 4 + j, acc[i][j]);
}

__global__ __launch_bounds__(256) void k_merge_gemm(const bf16* att, const bf16* ret, const float* Wa, const float* Wr, const bf16* GA, const bf16* GT, bf16* merged) {
    __shared__ float As[16][68];
    __shared__ float Bs[16][68];
    const int tid = threadIdx.x, tx = tid & 15, ty = tid >> 4;
    const int m0 = blockIdx.y * 64, n0 = blockIdx.x * 64;
    float acc[2][4][4];
#pragma unroll
    for (int p = 0; p < 2; ++p)
#pragma unroll
        for (int i = 0; i < 4; ++i)
#pragma unroll
            for (int j = 0; j < 4; ++j) acc[p][i][j] = 0.f;
#pragma unroll
    for (int p = 0; p < 2; ++p) {
        const bf16* A = p ? ret : att; const int lda = p ? 1024 : 512, K = lda; const float* B = p ? Wr : Wa;
        for (int k0 = 0; k0 < K; k0 += 16) {
            { const int r = tid >> 2, kk = (tid & 3) * 4; const ushort4 v = *(const ushort4*)(A + (size_t)(m0 + r) * lda + k0 + kk);
              As[kk + 0][r] = bf2f(v.x); As[kk + 1][r] = bf2f(v.y); As[kk + 2][r] = bf2f(v.z); As[kk + 3][r] = bf2f(v.w); }
            { const int kk = tid >> 4, nn = (tid & 15) * 4; const float4 v = *(const float4*)(B + (size_t)(k0 + kk) * 1024 + n0 + nn);
              Bs[kk][nn + 0] = v.x; Bs[kk][nn + 1] = v.y; Bs[kk][nn + 2] = v.z; Bs[kk][nn + 3] = v.w; }
            __syncthreads();
#pragma unroll
            for (int kk = 0; kk < 16; ++kk) {
                float a[4], b[4];
#pragma unroll
                for (int i = 0; i < 4; ++i) { a[i] = As[kk][ty * 4 + i]; b[i] = Bs[kk][tx * 4 + i]; }
#pragma unroll
                for (int i = 0; i < 4; ++i)
#pragma unroll
                    for (int j = 0; j < 4; ++j) acc[p][i][j] += a[i] * b[j];
            }
            __syncthreads();
        }
    }
#pragma unroll
    for (int i = 0; i < 4; ++i)
#pragma unroll
        for (int j = 0; j < 4; ++j) {
            const size_t o = (size_t)(m0 + ty * 4 + i) * 1024 + n0 + tx * 4 + j;
            const float ga = bf2f(GA[o]), gt = bf2f(GT[o]);
            const float sa = 1.f / (1.f + expf(-ga)), sr = 1.f / (1.f + expf(-gt));
            merged[o] = f2bf(sa * acc[0][i][j] + sr * acc[1][i][j]);
        }
}

__global__ __launch_bounds__(256) void k_attn_naive(const bf16* QA, const bf16* KVA, const float* tab, const float* sinks, bf16* ATT) {
    const int gid = blockIdx.x * 256 + threadIdx.x;
    const int hq = gid & 7, tg = gid >> 3, b = tg / SEQ, t = tg % SEQ, kvh = hq >> 2;
    const float* cosA = tab, *sinA = tab + 2048 * 8;
    float q[64];
    { const bf16* qp = QA + (size_t)tg * 512 + hq * 64;
#pragma unroll
      for (int d = 0; d < 64; ++d) q[d] = bf2f(qp[d]);
#pragma unroll
      for (int i = 0; i < 8; ++i) { const float c = cosA[t * 8 + i], s = sinA[t * 8 + i], x1 = q[i], x2 = q[i + 8]; q[i] = x1 * c - x2 * s; q[i + 8] = x2 * c + x1 * s; }
#pragma unroll
      for (int d = 0; d < 64; ++d) q[d] *= 0.125f; }
    float m = sinks[hq], l = 1.f, o[64];
#pragma unroll
    for (int d = 0; d < 64; ++d) o[d] = 0.f;
    const int j0 = t - 127 < 0 ? 0 : t - 127;
    for (int j = j0; j <= t; ++j) {
        const bf16* kp = KVA + (size_t)(b * SEQ + j) * 256 + kvh * 64;
        const bf16* vp = kp + 128;
        float s = 0.f;
#pragma unroll
        for (int i = 0; i < 8; ++i) { const float c = cosA[j * 8 + i], sn = sinA[j * 8 + i], x1 = bf2f(kp[i]), x2 = bf2f(kp[i + 8]); s += q[i] * (x1 * c - x2 * sn) + q[i + 8] * (x2 * c + x1 * sn); }
#pragma unroll
        for (int d = 16; d < 64; ++d) s += q[d] * bf2f(kp[d]);
        const float mn = fmaxf(m, s), corr = expf(m - mn), p = expf(s - mn);
        l = l * corr + p;
#pragma unroll
        for (int d = 0; d < 64; ++d) o[d] = o[d] * corr + p * bf2f(vp[d]);
        m = mn;
    }
    const float rl = 1.f / l;
    bf16* op = ATT + (size_t)tg * 512 + hq * 64;
#pragma unroll
    for (int d = 0; d < 64; ++d) op[d] = f2bf(o[d] * rl);
}

__global__ __launch_bounds__(256) void k_ret_naive(const bf16* QR, const bf16* KR, const bf16* VR, const bf16* GR, const float* tab, bf16* RET) {
    __shared__ float Ks[64][64];
    __shared__ float Vs[64][4][33];
    const float* cosR = tab + 2048 * 16, *sinR = tab + 2048 * 16 + 2048 * 32;
    const int tid = threadIdx.x, qi = tid >> 2, sl = tid & 3;
    const int qt = blockIdx.x, bh = blockIdx.y, b = bh >> 3, h = bh & 7;
    const int t = qt * 64 + qi; const size_t row = (size_t)b * SEQ + t;
    float q[64];
    { const bf16* qp = QR + row * 512 + h * 64;
#pragma unroll
      for (int d = 0; d < 64; ++d) q[d] = bf2f(qp[d]);
#pragma unroll
      for (int i = 0; i < 32; ++i) { const float c = cosR[t * 32 + i], s = sinR[t * 32 + i], x1 = q[i], x2 = q[i + 32]; q[i] = x1 * c - x2 * s; q[i + 32] = x2 * c + x1 * s; } }
    const float lg2 = log2f(1.0f - exp2f(-5.0f - (float)h));
    float acc[32];
#pragma unroll
    for (int e = 0; e < 32; ++e) acc[e] = 0.f;
    for (int kt = 0; kt <= qt; ++kt) {
        __syncthreads();
        { const int key = tid >> 2, i0 = (tid & 3) * 8; const int pos = kt * 64 + key; const bf16* kp = KR + ((size_t)b * SEQ + pos) * 512 + h * 64;
#pragma unroll
          for (int i = i0; i < i0 + 8; ++i) { const float c = cosR[pos * 32 + i], s = sinR[pos * 32 + i], x1 = bf2f(kp[i]), x2 = bf2f(kp[i + 32]);
              Ks[key][i] = (x1 * c - x2 * s) * 0.125f; Ks[key][i + 32] = (x2 * c + x1 * s) * 0.125f; }
          const bf16* vp = VR + ((size_t)b * SEQ + pos) * 1024 + h * 128 + (tid & 3) * 32;
#pragma unroll
          for (int e = 0; e < 32; ++e) Vs[key][tid & 3][e] = bf2f(vp[e]); }
        __syncthreads();
        const int mmax = (kt == qt) ? qi : 63;
        for (int m = 0; m < 64; ++m) {
            if (m <= mmax) {
                float s = 0.f;
#pragma unroll
                for (int d = 0; d < 64; ++d) s += q[d] * Ks[m][d];
                const float w = s * exp2f(lg2 * (float)(t - (kt * 64 + m)));
#pragma unroll
                for (int e = 0; e < 32; ++e) acc[e] += w * Vs[m][sl][e];
            }
        }
    }
    float ss = 0.f;
#pragma unroll
    for (int e = 0; e < 32; ++e) ss += acc[e] * acc[e];
    ss += __shfl_xor(ss, 1); ss += __shfl_xor(ss, 2);
    const float rs = 1.0f / sqrtf(ss * (1.0f / 128.0f) + EPS);
    const bf16* gp = GR + row * 1024 + h * 128 + sl * 32;
    bf16* op = RET + row * 1024 + h * 128 + sl * 32;
#pragma unroll
    for (int e = 0; e < 32; ++e) { const float g = bf2f(gp[e]); op[e] = f2bf(g / (1.f + expf(-g)) * acc[e] * rs); }
}

__global__ __launch_bounds__(256) void k_peer_route(const bf16* PQ, const float* K1, const float* K2, int* IDX, float* GATE) {
    __shared__ float sv[4][2][16];
    __shared__ int si[4][2][16];
    const int wv = threadIdx.x >> 6, lane = threadIdx.x & 63;
    const int th = blockIdx.x * 4 + wv, t = th >> 3, h = th & 7;
    const bf16* qp = PQ + (size_t)t * 2048 + h * 256;
    for (int p = 0; p < 2; ++p) {
        const float* Kp = p ? K2 : K1;
        float v0 = 0.f, v1 = 0.f;
        for (int c = 0; c < 128; ++c) { const float qc = bf2f(qp[p * 128 + c]); v0 += qc * Kp[lane * 128 + c]; v1 += qc * Kp[(lane + 64) * 128 + c]; }
        for (int r = 0; r < 16; ++r) {
            float bv; int bi;
            if (v0 >= v1) { bv = v0; bi = lane; } else { bv = v1; bi = lane + 64; }
#pragma unroll
            for (int off = 32; off >= 1; off >>= 1) { const float ov = __shfl_xor(bv, off); const int oi = __shfl_xor(bi, off); if (ov > bv || (ov == bv && oi < bi)) { bv = ov; bi = oi; } }
            if (lane == 0) { sv[wv][p][r] = bv; si[wv][p][r] = bi; }
            if (bi == lane) v0 = -INFINITY; else if (bi == lane + 64) v1 = -INFINITY;
        }
    }
    __syncthreads();
    float cv[4];
#pragma unroll
    for (int k = 0; k < 4; ++k) { const int c = lane + 64 * k; cv[k] = sv[wv][0][c >> 4] + sv[wv][1][c & 15]; }
    float tsc[16]; int tix[16];
#pragma unroll
    for (int r = 0; r < 16; ++r) {
        float bv = cv[0]; int bi = lane;
#pragma unroll
        for (int k = 1; k < 4; ++k) if (cv[k] > bv) { bv = cv[k]; bi = lane + 64 * k; }
#pragma unroll
        for (int off = 32; off >= 1; off >>= 1) { const float ov = __shfl_xor(bv, off); const int oi = __shfl_xor(bi, off); if (ov > bv || (ov == bv && oi < bi)) { bv = ov; bi = oi; } }
        tsc[r] = bv; tix[r] = bi;
#pragma unroll
        for (int k = 0; k < 4; ++k) if (bi == lane + 64 * k) cv[k] = -INFINITY;
    }
    float den = 0.f; const float tmx = tsc[0];
#pragma unroll
    for (int r = 0; r < 16; ++r) { tsc[r] = expf(tsc[r] - tmx); den += tsc[r]; }
    const float rden = 1.f / den;
#pragma unroll
    for (int r = 0; r < 16; ++r) if (lane == r) {
        const int c = tix[r];
        IDX[(size_t)t * 128 + h * 16 + r] = si[wv][0][c >> 4] * 128 + si[wv][1][c & 15];
        GATE[(size_t)t * 128 + h * 16 + r] = tsc[r] * rden;
    }
}

__global__ __launch_bounds__(512) void k_peer_apply(const bf16* HN2, const int* IDX, const float* GATE, const float* U, const float* V, const float* gfin, float* HOUT) {
    __shared__ float red[8][1024];
    __shared__ float wsum[8];
    const int t = blockIdx.x, h = threadIdx.x >> 6, lane = threadIdx.x & 63;
    float4 xv[4];
#pragma unroll
    for (int j = 0; j < 4; ++j) { const ushort4 u4 = ((const ushort4*)(HN2 + (size_t)t * DM))[lane + 64 * j]; xv[j] = make_float4(bf2f(u4.x), bf2f(u4.y), bf2f(u4.z), bf2f(u4.w)); }
    float4 acc[4];
#pragma unroll
    for (int j = 0; j < 4; ++j) acc[j] = make_float4(0.f, 0.f, 0.f, 0.f);
    for (int k = 0; k < 16; ++k) {
        const int e = IDX[(size_t)t * 128 + h * 16 + k]; const float g = GATE[(size_t)t * 128 + h * 16 + k];
        const float4* up = (const float4*)(U + (size_t)e * DM); const float4* vp = (const float4*)(V + (size_t)e * DM);
        float s = 0.f;
#pragma unroll
        for (int j = 0; j < 4; ++j) { const float4 u4 = up[lane + 64 * j]; s += u4.x * xv[j].x + u4.y * xv[j].y + u4.z * xv[j].z + u4.w * xv[j].w; }
        const float a = wave_sum(s);
        const float coef = g * 0.5f * a * (1.f + erff(a * 0.70710678118654752f));
#pragma unroll
        for (int j = 0; j < 4; ++j) { const float4 v4 = vp[lane + 64 * j]; acc[j].x += coef * v4.x; acc[j].y += coef * v4.y; acc[j].z += coef * v4.z; acc[j].w += coef * v4.w; }
    }
#pragma unroll
    for (int j = 0; j < 4; ++j) *(float4*)&red[h][(lane + 64 * j) * 4] = acc[j];
    __syncthreads();
    const int d0 = threadIdx.x * 2;
    float y0 = HOUT[(size_t)t * DM + d0], y1 = HOUT[(size_t)t * DM + d0 + 1];
#pragma unroll
    for (int w = 0; w < 8; ++w) { y0 += red[w][d0]; y1 += red[w][d0 + 1]; }
    float ss = wave_sum(y0 * y0 + y1 * y1);
    if (lane == 0) wsum[h] = ss;
    __syncthreads();
    float tot = 0.f;
#pragma unroll
    for (int w = 0; w < 8; ++w) tot += wsum[w];
    const float rstd = 1.0f / sqrtf(tot * (1.0f / DM) + EPS);
    HOUT[(size_t)t * DM + d0] = y0 * rstd * gfin[d0]; HOUT[(size_t)t * DM + d0 + 1] = y1 * rstd * gfin[d0 + 1];
}

extern "C" void kernel_launch(void* const* d_in, const int* in_sizes, int n_in, void* d_out, int out_size, void* d_ws, size_t ws_size, hipStream_t stream) {
    const float* x = (const float*)d_in[0]; const float* norm_mix = (const float*)d_in[1]; const float* w_in = (const float*)d_in[2]; const float* sinks = (const float*)d_in[3];
    const float* w_att = (const float*)d_in[4]; const float* w_ret = (const float*)d_in[5]; const float* w_out = (const float*)d_in[6]; const float* norm_ffn = (const float*)d_in[7];
    const float* wq = (const float*)d_in[8]; const float* k1 = (const float*)d_in[9]; const float* k2 = (const float*)d_in[10]; const float* pu = (const float*)d_in[11]; const float* pv = (const float*)d_in[12];
    const float* norm_final = (const float*)d_in[13];
    unsigned char* ws = (unsigned char*)d_ws; unsigned char* dob = (unsigned char*)d_out; float* out = (float*)d_out;
    if (ws_size < 256 * MiB) { fprintf(stderr, "ws too small\n"); return; }
    float* tab = (float*)(ws + WS_TAB);
    k_tables<<<(2048 * 40 + 255) / 256, 256, 0, stream>>>(tab);
    k_rms_rows<<<T / 4, 256, 0, stream>>>(x, norm_mix, (bf16*)(dob + DO_HN));
    k_gemm<EpiProj><<<dim3(INW / 64, T / 64), 256, 0, stream>>>((const bf16*)(dob + DO_HN), DM, w_in, INW, DM, EpiProj{ws});
    k_attn_naive<<<T * 8 / 256, 256, 0, stream>>>((const bf16*)(ws + WS_QA), (const bf16*)(ws + WS_KVA), tab, sinks, (bf16*)(dob + DO_ATT));
    k_ret_naive<<<dim3(SEQ / 64, BATCH * 8), 256, 0, stream>>>((const bf16*)(ws + WS_QR), (const bf16*)(ws + WS_KR), (const bf16*)(ws + WS_VR), (const bf16*)(ws + WS_GR), tab, (bf16*)(dob + DO_RET));
    k_merge_gemm<<<dim3(DM / 64, T / 64), 256, 0, stream>>>((const bf16*)(dob + DO_ATT), (const bf16*)(dob + DO_RET), w_att, w_ret, (const bf16*)(ws + WS_GA), (const bf16*)(ws + WS_GT), (bf16*)(ws + WS_MERGED));
    k_gemm<EpiResid><<<dim3(DM / 64, T / 64), 256, 0, stream>>>((const bf16*)(ws + WS_MERGED), DM, w_out, DM, DM, EpiResid{x, out});
    k_rms_rows<<<T / 4, 256, 0, stream>>>(out, norm_ffn, (bf16*)(ws + WS_HN2));
    k_gemm<EpiBf16><<<dim3(2048 / 64, T / 64), 256, 0, stream>>>((const bf16*)(ws + WS_HN2), DM, wq, 2048, DM, EpiBf16{(bf16*)(ws + WS_PQ), 2048});
    k_peer_route<<<T * 8 / 4, 256, 0, stream>>>((const bf16*)(ws + WS_PQ), k1, k2, (int*)(ws + WS_IDX), (float*)(ws + WS_GATE));
    k_peer_apply<<<T, 512, 0, stream>>>((const bf16*)(ws + WS_HN2), (const int*)(ws + WS_IDX), (const float*)(ws + WS_GATE), pu, pv, norm_final, out);
}
```

```cpp
#include <hip/hip_runtime.h>
#include <cstdint>
#include <cstdio>
namespace pg8 {
#define PG8_LAS __attribute__((address_space(3)))
typedef unsigned short bf16_t;
typedef short bf16x8 __attribute__((ext_vector_type(8)));
typedef float f32x4 __attribute__((ext_vector_type(4)));
typedef unsigned u32x4 __attribute__((ext_vector_type(4)));
constexpr int BM = 256, BK = 64, HALF = 128, HTB = HALF * BK * 2  , STAGE_BYTES = 8 * HTB, NXCD = 8, WGM = 8;

__host__ __device__ __forceinline__ int lds_byte(int r, int c) { const int st = (r >> 4) * 2 + (c >> 5), rr = r & 15, cc = c & 31, ob = rr * 64 + cc * 2; return st * 1024 + (ob ^ (((ob >> 9) & 1) << 5)); }
__host__ __device__ __forceinline__ void stage_rc(int b, int& R, int& C) { const int st = b / 1024, sb = b % 1024, swz = sb ^ (((sb >> 9) & 1) << 5); R = (st >> 1) * 16 + swz / 64; C = (st & 1) * 32 + (swz % 64) / 2; }
__host__ __device__ __forceinline__ int perm32(int rho) { const int n = rho >> 4, i = rho & 15; return 8 * (i >> 2) + 4 * n + (i & 3); }

struct Unit { int pm, pn; };
struct Gemm { const bf16_t* A; const bf16_t* Bt; int M, N, K; };

struct StaticOrder {
    int nM, nN, nwg, G, c;
    __host__ __device__ void init(int M, int N, int G_, int c_) { nM = M / BM; nN = N / BM; nwg = nM * nN; G = G_; c = c_; }
    __host__ __device__ bool next(int i, Unit& u) const {
        const long L = (long)i * G + c; if (L >= nwg) return false;
        int wgid = (int)L; { const int q = nwg / NXCD, r = nwg % NXCD, xcd = wgid % NXCD, off = wgid / NXCD; wgid = (xcd < r ? xcd * (q + 1) : r * (q + 1) + (xcd - r) * q) + off; }
        const int nig = WGM * nN, gid = wgid / nig, fm = gid * WGM, gsz = (nM - fm) < WGM ? (nM - fm) : WGM;
        u.pm = fm + ((wgid % nig) % gsz); u.pn = (wgid % nig) / gsz; return true;
    }
    __device__ __forceinline__ void a_ready(const Unit&) const {}
    __device__ __forceinline__ void done(const Unit&) const {}
};

__device__ __forceinline__ unsigned cvt_pk_bf16(float lo, float hi) { unsigned r; asm volatile("v_cvt_pk_bf16_f32 %0, %1, %2" : "=v"(r) : "v"(lo), "v"(hi)); return r; }
typedef float f32x2 __attribute__((ext_vector_type(2)));
template <class Epi, class Sched, bool ALIGN_EPI = false, bool SP2 = false>
__device__ __forceinline__ void gemm_phase(PG8_LAS unsigned char* lds, const Gemm g, const Sched& S, const Epi& E) {
    const int tid = threadIdx.x, wid = __builtin_amdgcn_readfirstlane(tid >> 6), lane = tid & 63, wr = wid >> 2, wc = wid & 3, fr = lane & 15, fq = lane >> 4;
    const int K = g.K, nt = K / BK;
    unsigned voffA[2], voffB[2];
#pragma unroll
    for (int i = 0; i < 2; ++i) { int R, C; stage_rc(tid * 16 + i * 8192, R, C); const int Rb = Epi::PERM ? ((R & ~31) + perm32(R & 31)) : R;
        voffA[i] = (unsigned)(R * K + C) * 2u; voffB[i] = (unsigned)(Rb * K + C) * 2u; }
    const size_t kstep = (size_t)(BK * 2);
    const size_t hstep = (size_t)HALF * K * 2;
    const size_t tstep = 2 * hstep;
    const unsigned ldsw = (unsigned)wid * 1024u;
    const int aoff = lds_byte(wr * 64 + fr, fq * 8), boff = lds_byte(wc * 32 + fr, fq * 8);
#define PG8_SA(b, h) (((b) * 2 + (h)) * HTB)
#define PG8_SB(b, h) ((4 + (b) * 2 + (h)) * HTB)
#define PG8_STAGE(bufoff, gbase, voff) do { _Pragma("unroll") for (int _i = 0; _i < 2; ++_i) \
        __builtin_amdgcn_global_load_lds((const unsigned*)((const char*)(gbase) + (voff)[_i]), (PG8_LAS unsigned*)(lds + (bufoff) + ldsw + _i * 8192), 16, 0, 0); } while (0)
#define PG8_LDA(dst, b, h) do { _Pragma("unroll") for (int m = 0; m < 4; ++m) _Pragma("unroll") for (int k = 0; k < 2; ++k) dst[m][k] = *(const PG8_LAS bf16x8*)(lds + PG8_SA(b, h) + aoff + m * 2048 + k * 1024); } while (0)
#define PG8_LDB(dst, b, h) do { _Pragma("unroll") for (int n = 0; n < 2; ++n) _Pragma("unroll") for (int k = 0; k < 2; ++k) dst[n][k] = *(const PG8_LAS bf16x8*)(lds + PG8_SB(b, h) + boff + n * 2048 + k * 1024); } while (0)
#define PG8_MMA(ai, bj, At, Bt) do { __builtin_amdgcn_s_setprio(1); _Pragma("unroll") for (int m = 0; m < 4; ++m) _Pragma("unroll") for (int n = 0; n < 2; ++n) _Pragma("unroll") for (int k = 0; k < 2; ++k) \
        acc[ai][bj][m][n] = __builtin_amdgcn_mfma_f32_16x16x32_bf16(Bt[n][k], At[m][k], acc[ai][bj][m][n], 0, 0, 0); __builtin_amdgcn_s_setprio(0); } while (0)
#define PG8_WAIT_V(n) asm volatile("s_waitcnt vmcnt(" #n ")" ::: "memory")
#define PG8_WAIT_L(n) asm volatile("s_waitcnt lgkmcnt(" #n ")" ::: "memory")
#define PG8_BAR __builtin_amdgcn_s_barrier()
#define PG8_SCHED __builtin_amdgcn_sched_barrier(0)
    Unit cur, nxt; int ui = 0;
    if (!S.next(0, cur)) return;
    f32x4 acc[2][2][4][2];
#pragma unroll
    for (int a = 0; a < 2; ++a)
#pragma unroll
        for (int b = 0; b < 2; ++b)
#pragma unroll
            for (int m = 0; m < 4; ++m)
#pragma unroll
                for (int n = 0; n < 2; ++n) acc[a][b][m][n] = (f32x4){0.f, 0.f, 0.f, 0.f};
    bf16x8 At[4][2], B0[2][2], B1[2][2];
    const char* cA = (const char*)g.A + (size_t)cur.pm * tstep; const char* cB = (const char*)g.Bt + (size_t)cur.pn * tstep;
    S.a_ready(cur);
    if constexpr (SP2) {
        PG8_STAGE(PG8_SB(0, 0), cB, voffB); PG8_STAGE(PG8_SB(0, 1), cB + hstep, voffB); PG8_STAGE(PG8_SA(0, 0), cA, voffA); PG8_STAGE(PG8_SA(0, 1), cA + hstep, voffA);
        if (wr == 1) PG8_BAR;
        PG8_WAIT_V(2); PG8_BAR;
        PG8_STAGE(PG8_SB(1, 0), cB + kstep, voffB); PG8_STAGE(PG8_SA(1, 0), cA + kstep, voffA); PG8_STAGE(PG8_SB(1, 1), cB + hstep + kstep, voffB);
        PG8_WAIT_V(6); PG8_BAR;
    } else {
        PG8_STAGE(PG8_SB(0, 0), cB, voffB); PG8_STAGE(PG8_SA(0, 0), cA, voffA); PG8_STAGE(PG8_SB(0, 1), cB + hstep, voffB); PG8_STAGE(PG8_SA(0, 1), cA + hstep, voffA);
        if (wr == 1) PG8_BAR;
        PG8_WAIT_V(4); PG8_BAR;
        PG8_STAGE(PG8_SB(1, 0), cB + kstep, voffB); PG8_STAGE(PG8_SA(1, 0), cA + kstep, voffA); PG8_STAGE(PG8_SB(1, 1), cB + hstep + kstep, voffB);
        PG8_WAIT_V(6); PG8_BAR;
    }
    for (;;) {
        const bool has_next = S.next(ui + 1, nxt);
        const char* nA = has_next ? (const char*)g.A + (size_t)nxt.pm * tstep : cA; const char* nB = has_next ? (const char*)g.Bt + (size_t)nxt.pn * tstep : cB;
        for (int t = 0; t < nt; t += 2) {
            const bool last = (t == nt - 2);
            const char* a1 = cA + (size_t)(t + 1) * kstep;
            const char* a2 = last ? nA : cA + (size_t)(t + 2) * kstep; const char* b2 = last ? nB : cB + (size_t)(t + 2) * kstep;
            const char* a3 = a2 + kstep; const char* b3 = b2 + kstep;
            if (last && has_next) S.a_ready(nxt);
            if constexpr (SP2) {
            PG8_LDB(B0, 0, 0); PG8_LDB(B1, 0, 1); PG8_SCHED; PG8_LDA(At, 0, 0); PG8_STAGE(PG8_SA(1, 1), a1 + hstep, voffA);
            PG8_WAIT_V(8); PG8_WAIT_L(0); PG8_BAR; PG8_MMA(0, 0, At, B0); PG8_MMA(0, 1, At, B1); PG8_BAR; PG8_SCHED;
            PG8_LDA(At, 0, 1); PG8_STAGE(PG8_SB(0, 0), b2, voffB); PG8_STAGE(PG8_SB(0, 1), b2 + hstep, voffB); PG8_STAGE(PG8_SA(0, 0), a2, voffA);
            PG8_WAIT_V(8); PG8_WAIT_L(0); PG8_BAR; PG8_MMA(1, 0, At, B0); PG8_MMA(1, 1, At, B1); PG8_BAR; PG8_SCHED;
            PG8_LDB(B0, 1, 0); PG8_LDB(B1, 1, 1); PG8_SCHED; PG8_LDA(At, 1, 0); PG8_STAGE(PG8_SA(0, 1), a2 + hstep, voffA);
            PG8_WAIT_V(8); PG8_WAIT_L(0); PG8_BAR; PG8_MMA(0, 0, At, B0); PG8_MMA(0, 1, At, B1); PG8_BAR; PG8_SCHED;
            PG8_LDA(At, 1, 1); PG8_STAGE(PG8_SB(1, 0), b3, voffB); PG8_STAGE(PG8_SB(1, 1), b3 + hstep, voffB); PG8_STAGE(PG8_SA(1, 0), a3, voffA);
            PG8_WAIT_V(8); PG8_WAIT_L(0); PG8_BAR; PG8_MMA(1, 0, At, B0); PG8_MMA(1, 1, At, B1); PG8_BAR; PG8_SCHED;
            } else {
            PG8_LDB(B0, 0, 0); PG8_SCHED; PG8_LDA(At, 0, 0); PG8_STAGE(PG8_SA(1, 1), a1 + hstep, voffA);
            PG8_WAIT_L(8); PG8_BAR; PG8_WAIT_L(0); PG8_MMA(0, 0, At, B0); PG8_BAR; PG8_SCHED;
            PG8_LDB(B1, 0, 1); PG8_STAGE(PG8_SB(0, 0), b2, voffB);
            PG8_BAR; PG8_WAIT_L(0); PG8_MMA(0, 1, At, B1); PG8_BAR;
            PG8_LDA(At, 0, 1); PG8_STAGE(PG8_SA(0, 0), a2, voffA);
            PG8_BAR; PG8_WAIT_L(0); PG8_MMA(1, 0, At, B0); PG8_BAR; PG8_SCHED;
            PG8_STAGE(PG8_SB(0, 1), b2 + hstep, voffB);
            PG8_WAIT_V(6); PG8_BAR; PG8_MMA(1, 1, At, B1); PG8_BAR;
            PG8_LDB(B0, 1, 0); PG8_SCHED; PG8_LDA(At, 1, 0); PG8_STAGE(PG8_SA(0, 1), a2 + hstep, voffA);
            PG8_WAIT_L(8); PG8_BAR; PG8_WAIT_L(0); PG8_MMA(0, 0, At, B0); PG8_BAR; PG8_SCHED;
            PG8_LDB(B1, 1, 1); PG8_STAGE(PG8_SB(1, 0), b3, voffB);
            PG8_BAR; PG8_WAIT_L(0); PG8_MMA(0, 1, At, B1); PG8_BAR;
            PG8_LDA(At, 1, 1); PG8_STAGE(PG8_SA(1, 0), a3, voffA);
            PG8_BAR; PG8_WAIT_L(0); PG8_MMA(1, 0, At, B0); PG8_BAR; PG8_SCHED;
            PG8_STAGE(PG8_SB(1, 1), b3 + hstep, voffB);
            PG8_WAIT_V(6); PG8_BAR; PG8_MMA(1, 1, At, B1); PG8_BAR;
            }
        }
        if constexpr (ALIGN_EPI) { if (wr == 0) PG8_BAR; }
        if constexpr (!Epi::AFTER_DRAIN) { E(acc, cur, wr, wc, fr, fq); S.done(cur); }
        if (!has_next) break;
#pragma unroll
        for (int a = 0; a < 2; ++a)
#pragma unroll
            for (int b = 0; b < 2; ++b)
#pragma unroll
                for (int m = 0; m < 4; ++m)
#pragma unroll
                    for (int n = 0; n < 2; ++n) acc[a][b][m][n] = (f32x4){0.f, 0.f, 0.f, 0.f};
        cur = nxt; cA = nA; cB = nB; ++ui;
        if constexpr (ALIGN_EPI) { if (wr == 1) PG8_BAR; }
    }
    PG8_WAIT_V(0);
    if constexpr (!ALIGN_EPI) { if (wr == 0) PG8_BAR; }
    PG8_BAR;
    if constexpr (Epi::AFTER_DRAIN) { E.fused(acc, cur, wr, wc, fr, fq, lds, wid, lane); S.done(cur); }
#undef PG8_SA
#undef PG8_SB
#undef PG8_STAGE
#undef PG8_LDA
#undef PG8_LDB
#undef PG8_MMA
#undef PG8_WAIT_V
#undef PG8_WAIT_L
#undef PG8_BAR
#undef PG8_SCHED
}
struct Gemm8 { const unsigned char* A; const unsigned char* Bt; int M, N, K; };
typedef int i32x8 __attribute__((ext_vector_type(8)));
typedef int i32x4 __attribute__((ext_vector_type(4)));
template <class Epi, class Sched>
__device__ __forceinline__ void gemm_phase_f8(PG8_LAS unsigned char* lds, const Gemm8 g, const Sched& S, const Epi& E) {
    constexpr bool ALIGN_EPI = true, SP2 = true;
    const int tid = threadIdx.x, wid = __builtin_amdgcn_readfirstlane(tid >> 6), lane = tid & 63, wr = wid >> 2, wc = wid & 3, fr = lane & 15, fq = lane >> 4;
    int K_ = g.K; asm volatile("" : "+s"(K_));
    const int K = K_, nt = K / 128;
    unsigned voffA[2], voffB[2];
#pragma unroll
    for (int i = 0; i < 2; ++i) { int R, C; stage_rc(tid * 16 + i * 8192, R, C); const int Rb = Epi::PERM ? ((R & ~31) + perm32(R & 31)) : R;
        voffA[i] = (unsigned)(R * K + C * 2); voffB[i] = (unsigned)(Rb * K + C * 2); }
    const size_t kstep = (size_t)(BK * 2);
    const size_t hstep = (size_t)HALF * K;
    const size_t tstep = 2 * hstep;
    const unsigned ldsw = (unsigned)wid * 1024u;
    const int aoff = lds_byte(wr * 64 + fr, fq * 8), boff = lds_byte(wc * 32 + fr, fq * 8);
#define PG8_SA(b, h) (((b) * 2 + (h)) * HTB)
#define PG8_SB(b, h) ((4 + (b) * 2 + (h)) * HTB)
#define PG8_STAGE(bufoff, gbase, voff) do { _Pragma("unroll") for (int _i = 0; _i < 2; ++_i) \
        __builtin_amdgcn_global_load_lds((const unsigned*)((const char*)(gbase) + (voff)[_i]), (PG8_LAS unsigned*)(lds + (bufoff) + ldsw + _i * 8192), 16, 0, 0); } while (0)
#define PG8_LDA(dst, b, h) do { _Pragma("unroll") for (int m = 0; m < 4; ++m) { const i32x4 lo_ = *(const PG8_LAS i32x4*)(lds + PG8_SA(b, h) + aoff + m * 2048), hi_ = *(const PG8_LAS i32x4*)(lds + PG8_SA(b, h) + aoff + m * 2048 + 1024); dst[m] = __builtin_shufflevector(lo_, hi_, 0, 1, 2, 3, 4, 5, 6, 7); } } while (0)
#define PG8_LDB(dst, b, h) do { _Pragma("unroll") for (int n = 0; n < 2; ++n) { const i32x4 lo_ = *(const PG8_LAS i32x4*)(lds + PG8_SB(b, h) + boff + n * 2048), hi_ = *(const PG8_LAS i32x4*)(lds + PG8_SB(b, h) + boff + n * 2048 + 1024); dst[n] = __builtin_shufflevector(lo_, hi_, 0, 1, 2, 3, 4, 5, 6, 7); } } while (0)
#define PG8_MMA(ai, bj, At, Bt) do { __builtin_amdgcn_s_setprio(1); _Pragma("unroll") for (int m = 0; m < 4; ++m) _Pragma("unroll") for (int n = 0; n < 2; ++n) \
        asm volatile("v_mfma_f32_16x16x128_f8f6f4 %0, %1, %2, %0" : "+v"(acc[ai][bj][m][n]) : "v"(Bt[n]), "v"(At[m])); __builtin_amdgcn_s_setprio(0); } while (0)
#define PG8_WAIT_V(n) asm volatile("s_waitcnt vmcnt(" #n ")" ::: "memory")
#define PG8_WAIT_L(n) asm volatile("s_waitcnt lgkmcnt(" #n ")" ::: "memory")
#define PG8_BAR __builtin_amdgcn_s_barrier()
#define PG8_SCHED __builtin_amdgcn_sched_barrier(0)
    Unit cur, nxt; int ui = 0;
    if (!S.next(0, cur)) return;
    f32x4 acc[2][2][4][2];
#pragma unroll
    for (int a = 0; a < 2; ++a)
#pragma unroll
        for (int b = 0; b < 2; ++b)
#pragma unroll
            for (int m = 0; m < 4; ++m)
#pragma unroll
                for (int n = 0; n < 2; ++n) acc[a][b][m][n] = (f32x4){0.f, 0.f, 0.f, 0.f};
    i32x8 At[4], B0[2], B1[2];
    const char* cA = (const char*)g.A + (size_t)cur.pm * tstep; const char* cB = (const char*)g.Bt + (size_t)cur.pn * tstep;
    S.a_ready(cur);
    if constexpr (SP2) {
        PG8_STAGE(PG8_SB(0, 0), cB, voffB); PG8_STAGE(PG8_SB(0, 1), cB + hstep, voffB); PG8_STAGE(PG8_SA(0, 0), cA, voffA); PG8_STAGE(PG8_SA(0, 1), cA + hstep, voffA);
        if (wr == 1) PG8_BAR;
        PG8_WAIT_V(2); PG8_BAR;
        PG8_STAGE(PG8_SB(1, 0), cB + kstep, voffB); PG8_STAGE(PG8_SA(1, 0), cA + kstep, voffA); PG8_STAGE(PG8_SB(1, 1), cB + hstep + kstep, voffB);
        PG8_WAIT_V(6); PG8_BAR;
    } else {
        PG8_STAGE(PG8_SB(0, 0), cB, voffB); PG8_STAGE(PG8_SA(0, 0), cA, voffA); PG8_STAGE(PG8_SB(0, 1), cB + hstep, voffB); PG8_STAGE(PG8_SA(0, 1), cA + hstep, voffA);
        if (wr == 1) PG8_BAR;
        PG8_WAIT_V(4); PG8_BAR;
        PG8_STAGE(PG8_SB(1, 0), cB + kstep, voffB); PG8_STAGE(PG8_SA(1, 0), cA + kstep, voffA); PG8_STAGE(PG8_SB(1, 1), cB + hstep + kstep, voffB);
        PG8_WAIT_V(6); PG8_BAR;
    }
    for (;;) {
        const bool has_next = S.next(ui + 1, nxt);
        const char* nA = has_next ? (const char*)g.A + (size_t)nxt.pm * tstep : cA; const char* nB = has_next ? (const char*)g.Bt + (size_t)nxt.pn * tstep : cB;
#pragma unroll 1
        for (int t = 0; t < nt; t += 2) {
            const bool last = (t == nt - 2);
            const char* a1 = cA + (size_t)(t + 1) * kstep;
            const char* a2 = last ? nA : cA + (size_t)(t + 2) * kstep; const char* b2 = last ? nB : cB + (size_t)(t + 2) * kstep;
            const char* a3 = a2 + kstep; const char* b3 = b2 + kstep;
            if (last && has_next) S.a_ready(nxt);
            if constexpr (SP2) {
            PG8_LDB(B0, 0, 0); PG8_LDB(B1, 0, 1); PG8_SCHED; PG8_LDA(At, 0, 0); PG8_STAGE(PG8_SA(1, 1), a1 + hstep, voffA);
            PG8_WAIT_V(8); PG8_WAIT_L(0); PG8_BAR; PG8_MMA(0, 0, At, B0); PG8_MMA(0, 1, At, B1); PG8_BAR; PG8_SCHED;
            PG8_LDA(At, 0, 1); PG8_STAGE(PG8_SB(0, 0), b2, voffB); PG8_STAGE(PG8_SB(0, 1), b2 + hstep, voffB); PG8_STAGE(PG8_SA(0, 0), a2, voffA);
            PG8_WAIT_V(8); PG8_WAIT_L(0); PG8_BAR; PG8_MMA(1, 0, At, B0); PG8_MMA(1, 1, At, B1); PG8_BAR; PG8_SCHED;
            PG8_LDB(B0, 1, 0); PG8_LDB(B1, 1, 1); PG8_SCHED; PG8_LDA(At, 1, 0); PG8_STAGE(PG8_SA(0, 1), a2 + hstep, voffA);
            PG8_WAIT_V(8); PG8_WAIT_L(0); PG8_BAR; PG8_MMA(0, 0, At, B0); PG8_MMA(0, 1, At, B1); PG8_BAR; PG8_SCHED;
            PG8_LDA(At, 1, 1); PG8_STAGE(PG8_SB(1, 0), b3, voffB); PG8_STAGE(PG8_SB(1, 1), b3 + hstep, voffB); PG8_STAGE(PG8_SA(1, 0), a3, voffA);
            PG8_WAIT_V(8); PG8_WAIT_L(0); PG8_BAR; PG8_MMA(1, 0, At, B0); PG8_MMA(1, 1, At, B1); PG8_BAR; PG8_SCHED;
            } else {
            PG8_LDB(B0, 0, 0); PG8_SCHED; PG8_LDA(At, 0, 0); PG8_STAGE(PG8_SA(1, 1), a1 + hstep, voffA);
            PG8_WAIT_L(8); PG8_BAR; PG8_WAIT_L(0); PG8_MMA(0, 0, At, B0); PG8_BAR; PG8_SCHED;
            PG8_LDB(B1, 0, 1); PG8_STAGE(PG8_SB(0, 0), b2, voffB);
            PG8_BAR; PG8_WAIT_L(0); PG8_MMA(0, 1, At, B1); PG8_BAR;
            PG8_LDA(At, 0, 1); PG8_STAGE(PG8_SA(0, 0), a2, voffA);
            PG8_BAR; PG8_WAIT_L(0); PG8_MMA(1, 0, At, B0); PG8_BAR; PG8_SCHED;
            PG8_STAGE(PG8_SB(0, 1), b2 + hstep, voffB);
            PG8_WAIT_V(6); PG8_BAR; PG8_MMA(1, 1, At, B1); PG8_BAR;
            PG8_LDB(B0, 1, 0); PG8_SCHED; PG8_LDA(At, 1, 0); PG8_STAGE(PG8_SA(0, 1), a2 + hstep, voffA);
            PG8_WAIT_L(8); PG8_BAR; PG8_WAIT_L(0); PG8_MMA(0, 0, At, B0); PG8_BAR; PG8_SCHED;
            PG8_LDB(B1, 1, 1); PG8_STAGE(PG8_SB(1, 0), b3, voffB);
            PG8_BAR; PG8_WAIT_L(0); PG8_MMA(0, 1, At, B1); PG8_BAR;
            PG8_LDA(At, 1, 1); PG8_STAGE(PG8_SA(1, 0), a3, voffA);
            PG8_BAR; PG8_WAIT_L(0); PG8_MMA(1, 0, At, B0); PG8_BAR; PG8_SCHED;
            PG8_STAGE(PG8_SB(1, 1), b3 + hstep, voffB);
            PG8_WAIT_V(6); PG8_BAR; PG8_MMA(1, 1, At, B1); PG8_BAR;
            }
        }
        if constexpr (ALIGN_EPI) { if (wr == 0) PG8_BAR; }
        asm volatile("s_nop 15\n\ts_nop 15" ::: "memory");
#pragma unroll
        for (int a_ = 0; a_ < 2; ++a_)
#pragma unroll
            for (int b_ = 0; b_ < 2; ++b_)
                asm volatile("" : "+v"(acc[a_][b_][0][0]), "+v"(acc[a_][b_][0][1]), "+v"(acc[a_][b_][1][0]), "+v"(acc[a_][b_][1][1]), "+v"(acc[a_][b_][2][0]), "+v"(acc[a_][b_][2][1]), "+v"(acc[a_][b_][3][0]), "+v"(acc[a_][b_][3][1]));
        if constexpr (!Epi::AFTER_DRAIN) { E(acc, cur, wr, wc, fr, fq); S.done(cur); }
        if (!has_next) break;
#pragma unroll
        for (int a = 0; a < 2; ++a)
#pragma unroll
            for (int b = 0; b < 2; ++b)
#pragma unroll
                for (int m = 0; m < 4; ++m)
#pragma unroll
                    for (int n = 0; n < 2; ++n) acc[a][b][m][n] = (f32x4){0.f, 0.f, 0.f, 0.f};
        cur = nxt; cA = nA; cB = nB; ++ui;
        if constexpr (ALIGN_EPI) { if (wr == 1) PG8_BAR; }
    }
    PG8_WAIT_V(0);
    if constexpr (!ALIGN_EPI) { if (wr == 0) PG8_BAR; }
    PG8_BAR;
    if constexpr (Epi::AFTER_DRAIN) { E.fused(acc, cur, wr, wc, fr, fq, lds, wid, lane); S.done(cur); }
#undef PG8_SA
#undef PG8_SB
#undef PG8_STAGE
#undef PG8_LDA
#undef PG8_LDB
#undef PG8_MMA
#undef PG8_WAIT_V
#undef PG8_WAIT_L
#undef PG8_BAR
#undef PG8_SCHED
}
template <class Epi, class Sched>
__device__ __forceinline__ void gemm_phase_i8(PG8_LAS unsigned char* lds, const Gemm8 g, const Sched& S, const Epi& E) {
    constexpr bool ALIGN_EPI = true, SP2 = true;
    const int tid = threadIdx.x, wid = __builtin_amdgcn_readfirstlane(tid >> 6), lane = tid & 63, wr = wid >> 2, wc = wid & 3, fr = lane & 15, fq = lane >> 4;
    int K_ = g.K; asm volatile("" : "+s"(K_));
    const int K = K_, nt = K / 128;
    unsigned voffA[2], voffB[2];
#pragma unroll
    for (int i = 0; i < 2; ++i) { int R, C; stage_rc(tid * 16 + i * 8192, R, C); const int Rb = Epi::PERM ? ((R & ~31) + perm32(R & 31)) : R;
        voffA[i] = (unsigned)(R * K + C * 2); voffB[i] = (unsigned)(Rb * K + C * 2); }
    const size_t kstep = (size_t)(BK * 2);
    const size_t hstep = (size_t)HALF * K;
    const size_t tstep = 2 * hstep;
    const unsigned ldsw = (unsigned)wid * 1024u;
    const int aoff = lds_byte(wr * 64 + fr, fq * 8), boff = lds_byte(wc * 32 + fr, fq * 8);
#define PG8_SA(b, h) (((b) * 2 + (h)) * HTB)
#define PG8_SB(b, h) ((4 + (b) * 2 + (h)) * HTB)
#define PG8_STAGE(bufoff, gbase, voff) do { _Pragma("unroll") for (int _i = 0; _i < 2; ++_i) \
        __builtin_amdgcn_global_load_lds((const unsigned*)((const char*)(gbase) + (voff)[_i]), (PG8_LAS unsigned*)(lds + (bufoff) + ldsw + _i * 8192), 16, 0, 0); } while (0)
#define PG8_LDA(dst, b, h) do { _Pragma("unroll") for (int m = 0; m < 4; ++m) _Pragma("unroll") for (int k = 0; k < 2; ++k) dst[m][k] = *(const PG8_LAS i32x4*)(lds + PG8_SA(b, h) + aoff + m * 2048 + k * 1024); } while (0)
#define PG8_LDB(dst, b, h) do { _Pragma("unroll") for (int n = 0; n < 2; ++n) _Pragma("unroll") for (int k = 0; k < 2; ++k) dst[n][k] = *(const PG8_LAS i32x4*)(lds + PG8_SB(b, h) + boff + n * 2048 + k * 1024); } while (0)
#define PG8_MMA(ai, bj, At, Bt) do { __builtin_amdgcn_s_setprio(1); _Pragma("unroll") for (int m = 0; m < 4; ++m) _Pragma("unroll") for (int n = 0; n < 2; ++n) _Pragma("unroll") for (int k = 0; k < 2; ++k) \
        acc[ai][bj][m][n] = __builtin_amdgcn_mfma_i32_16x16x64_i8(Bt[n][k], At[m][k], acc[ai][bj][m][n], 0, 0, 0); __builtin_amdgcn_s_setprio(0); } while (0)
#define PG8_WAIT_V(n) asm volatile("s_waitcnt vmcnt(" #n ")" ::: "memory")
#define PG8_WAIT_L(n) asm volatile("s_waitcnt lgkmcnt(" #n ")" ::: "memory")
#define PG8_BAR __builtin_amdgcn_s_barrier()
#define PG8_SCHED __builtin_amdgcn_sched_barrier(0)
    Unit cur, nxt; int ui = 0;
    if (!S.next(0, cur)) return;
    i32x4 acc[2][2][4][2];
#pragma unroll
    for (int a = 0; a < 2; ++a)
#pragma unroll
        for (int b = 0; b < 2; ++b)
#pragma unroll
            for (int m = 0; m < 4; ++m)
#pragma unroll
                for (int n = 0; n < 2; ++n) acc[a][b][m][n] = (i32x4){0, 0, 0, 0};
    i32x4 At[4][2], B0[2][2], B1[2][2];
    const char* cA = (const char*)g.A + (size_t)cur.pm * tstep; const char* cB = (const char*)g.Bt + (size_t)cur.pn * tstep;
    S.a_ready(cur);
    if constexpr (SP2) {
        PG8_STAGE(PG8_SB(0, 0), cB, voffB); PG8_STAGE(PG8_SB(0, 1), cB + hstep, voffB); PG8_STAGE(PG8_SA(0, 0), cA, voffA); PG8_STAGE(PG8_SA(0, 1), cA + hstep, voffA);
        if (wr == 1) PG8_BAR;
        PG8_WAIT_V(2); PG8_BAR;
        PG8_STAGE(PG8_SB(1, 0), cB + kstep, voffB); PG8_STAGE(PG8_SA(1, 0), cA + kstep, voffA); PG8_STAGE(PG8_SB(1, 1), cB + hstep + kstep, voffB);
        PG8_WAIT_V(6); PG8_BAR;
    } else {
        PG8_STAGE(PG8_SB(0, 0), cB, voffB); PG8_STAGE(PG8_SA(0, 0), cA, voffA); PG8_STAGE(PG8_SB(0, 1), cB + hstep, voffB); PG8_STAGE(PG8_SA(0, 1), cA + hstep, voffA);
        if (wr == 1) PG8_BAR;
        PG8_WAIT_V(4); PG8_BAR;
        PG8_STAGE(PG8_SB(1, 0), cB + kstep, voffB); PG8_STAGE(PG8_SA(1, 0), cA + kstep, voffA); PG8_STAGE(PG8_SB(1, 1), cB + hstep + kstep, voffB);
        PG8_WAIT_V(6); PG8_BAR;
    }
    for (;;) {
        const bool has_next = S.next(ui + 1, nxt);
        const char* nA = has_next ? (const char*)g.A + (size_t)nxt.pm * tstep : cA; const char* nB = has_next ? (const char*)g.Bt + (size_t)nxt.pn * tstep : cB;
#pragma unroll 1
        for (int t = 0; t < nt; t += 2) {
            const bool last = (t == nt - 2);
            const char* a1 = cA + (size_t)(t + 1) * kstep;
            const char* a2 = last ? nA : cA + (size_t)(t + 2) * kstep; const char* b2 = last ? nB : cB + (size_t)(t + 2) * kstep;
            const char* a3 = a2 + kstep; const char* b3 = b2 + kstep;
            if (last && has_next) S.a_ready(nxt);
            if constexpr (SP2) {
            PG8_LDB(B0, 0, 0); PG8_LDB(B1, 0, 1); PG8_SCHED; PG8_LDA(At, 0, 0); PG8_STAGE(PG8_SA(1, 1), a1 + hstep, voffA);
            PG8_WAIT_V(8); PG8_WAIT_L(0); PG8_BAR; PG8_MMA(0, 0, At, B0); PG8_MMA(0, 1, At, B1); PG8_BAR; PG8_SCHED;
            PG8_LDA(At, 0, 1); PG8_STAGE(PG8_SB(0, 0), b2, voffB); PG8_STAGE(PG8_SB(0, 1), b2 + hstep, voffB); PG8_STAGE(PG8_SA(0, 0), a2, voffA);
            PG8_WAIT_V(8); PG8_WAIT_L(0); PG8_BAR; PG8_MMA(1, 0, At, B0); PG8_MMA(1, 1, At, B1); PG8_BAR; PG8_SCHED;
            PG8_LDB(B0, 1, 0); PG8_LDB(B1, 1, 1); PG8_SCHED; PG8_LDA(At, 1, 0); PG8_STAGE(PG8_SA(0, 1), a2 + hstep, voffA);
            PG8_WAIT_V(8); PG8_WAIT_L(0); PG8_BAR; PG8_MMA(0, 0, At, B0); PG8_MMA(0, 1, At, B1); PG8_BAR; PG8_SCHED;
            PG8_LDA(At, 1, 1); PG8_STAGE(PG8_SB(1, 0), b3, voffB); PG8_STAGE(PG8_SB(1, 1), b3 + hstep, voffB); PG8_STAGE(PG8_SA(1, 0), a3, voffA);
            PG8_WAIT_V(8); PG8_WAIT_L(0); PG8_BAR; PG8_MMA(1, 0, At, B0); PG8_MMA(1, 1, At, B1); PG8_BAR; PG8_SCHED;
            } else {
            PG8_LDB(B0, 0, 0); PG8_SCHED; PG8_LDA(At, 0, 0); PG8_STAGE(PG8_SA(1, 1), a1 + hstep, voffA);
            PG8_WAIT_L(8); PG8_BAR; PG8_WAIT_L(0); PG8_MMA(0, 0, At, B0); PG8_BAR; PG8_SCHED;
            PG8_LDB(B1, 0, 1); PG8_STAGE(PG8_SB(0, 0), b2, voffB);
            PG8_BAR; PG8_WAIT_L(0); PG8_MMA(0, 1, At, B1); PG8_BAR;
            PG8_LDA(At, 0, 1); PG8_STAGE(PG8_SA(0, 0), a2, voffA);
            PG8_BAR; PG8_WAIT_L(0); PG8_MMA(1, 0, At, B0); PG8_BAR; PG8_SCHED;
            PG8_STAGE(PG8_SB(0, 1), b2 + hstep, voffB);
            PG8_WAIT_V(6); PG8_BAR; PG8_MMA(1, 1, At, B1); PG8_BAR;
            PG8_LDB(B0, 1, 0); PG8_SCHED; PG8_LDA(At, 1, 0); PG8_STAGE(PG8_SA(0, 1), a2 + hstep, voffA);
            PG8_WAIT_L(8); PG8_BAR; PG8_WAIT_L(0); PG8_MMA(0, 0, At, B0); PG8_BAR; PG8_SCHED;
            PG8_LDB(B1, 1, 1); PG8_STAGE(PG8_SB(1, 0), b3, voffB);
            PG8_BAR; PG8_WAIT_L(0); PG8_MMA(0, 1, At, B1); PG8_BAR;
            PG8_LDA(At, 1, 1); PG8_STAGE(PG8_SA(1, 0), a3, voffA);
            PG8_BAR; PG8_WAIT_L(0); PG8_MMA(1, 0, At, B0); PG8_BAR; PG8_SCHED;
            PG8_STAGE(PG8_SB(1, 1), b3 + hstep, voffB);
            PG8_WAIT_V(6); PG8_BAR; PG8_MMA(1, 1, At, B1); PG8_BAR;
            }
        }
        if constexpr (ALIGN_EPI) { if (wr == 0) PG8_BAR; }
        if constexpr (!Epi::AFTER_DRAIN) { E(acc, cur, wr, wc, fr, fq); S.done(cur); }
        if (!has_next) break;
#pragma unroll
        for (int a = 0; a < 2; ++a)
#pragma unroll
            for (int b = 0; b < 2; ++b)
#pragma unroll
                for (int m = 0; m < 4; ++m)
#pragma unroll
                    for (int n = 0; n < 2; ++n) acc[a][b][m][n] = (i32x4){0, 0, 0, 0};
        cur = nxt; cA = nA; cB = nB; ++ui;
        if constexpr (ALIGN_EPI) { if (wr == 1) PG8_BAR; }
    }
    PG8_WAIT_V(0);
    if constexpr (!ALIGN_EPI) { if (wr == 0) PG8_BAR; }
    PG8_BAR;
    if constexpr (Epi::AFTER_DRAIN) { E.fused(acc, cur, wr, wc, fr, fq, lds, wid, lane); S.done(cur); }
#undef PG8_SA
#undef PG8_SB
#undef PG8_STAGE
#undef PG8_LDA
#undef PG8_LDB
#undef PG8_MMA
#undef PG8_WAIT_V
#undef PG8_WAIT_L
#undef PG8_BAR
#undef PG8_SCHED
}
}
constexpr int BATCH = 8, SEQ = 2048, DM = 1024, T = BATCH * SEQ;
constexpr int INW = 5888;
constexpr float EPS = 1e-6f;
constexpr size_t MiB = 1u << 20;
constexpr size_t WS_CTL = 0, CTL_ZERO_BYTES = 64 * 1024;
constexpr size_t WS_TAB = 1 * MiB;
constexpr size_t WS_K1 = 13 * MiB + 512 * 1024, WS_K2 = WS_K1 + 65536;
constexpr size_t WS_WIN = 2 * MiB, WS_WA = 14 * MiB  , WS_WR = 16 * MiB, WS_WO = 18 * MiB, WS_WQ = 20 * MiB;
constexpr size_t WS_QA = 24 * MiB, WS_KVA = 40 * MiB, WS_QR = 48 * MiB, WS_KR = 64 * MiB, WS_VR = 80 * MiB, WS_GR = 112 * MiB, WS_GA = 144 * MiB;
constexpr size_t WS_U4 = 200 * MiB, WS_V4 = 208 * MiB;
constexpr size_t WS_SU = WS_TAB + 768 * 1024, WS_SV = WS_SU + 65536;
constexpr size_t WS_SS2 = WS_SV + 65536;
constexpr size_t WS_HN8 = 176 * MiB, WS_WIN8 = 192 * MiB, WS_CSC = 198 * MiB  , WS_RSC = WS_TAB + 960 * 1024  ;
constexpr size_t WS_ATT = 216 * MiB;
constexpr size_t WS_RET = WS_VR  , WS_MERGED = WS_QA, WS_HN2 = WS_GR, WS_PQ = WS_QA  , WS_IDX = 88 * MiB, WS_GATE = 96 * MiB;
constexpr size_t DO_HN = 0, DO_KVT = 0  , DO_YA = 0  , DO_GT = 32 * MiB;
constexpr int CW_BAR = 4096;
namespace pg8 {
typedef unsigned u32x2 __attribute__((ext_vector_type(2)));
__device__ __forceinline__ float sigm(float g) { return 1.0f / (1.0f + __expf(-g)); }
__device__ __forceinline__ float bflo(unsigned w) { return __builtin_bit_cast(float, w << 16); }
__device__ __forceinline__ float bfhi(unsigned w) { return __builtin_bit_cast(float, w & 0xffff0000u); }
struct EpiProj {
    static constexpr bool PERM = true, AFTER_DRAIN = false;
    unsigned char* ws; unsigned char* gt;
    __device__ __forceinline__ void operator()(const f32x4 (&acc)[2][2][4][2], const Unit& u, int wr, int wc, int fr, int fq) const {
        const int pn = u.pn; size_t off = 0; int ld, ct;
        if (pn < 2) { off = WS_QA; ld = 512; ct = pn; } else if (pn < 3) { off = WS_KVA; ld = 256; ct = 0; } else if (pn < 5) { off = WS_QR; ld = 512; ct = pn - 3; }
        else if (pn < 7) { off = WS_KR; ld = 512; ct = pn - 5; } else if (pn < 11) { off = WS_VR; ld = 1024; ct = pn - 7; } else if (pn < 15) { off = WS_GR; ld = 1024; ct = pn - 11; }
        else if (pn < 19) { off = WS_GA; ld = 1024; ct = pn - 15; } else { ld = 1024; ct = pn - 19; }
        bf16_t* base = pn < 19 ? (bf16_t*)(ws + off) : (bf16_t*)gt;
        const int row0 = u.pm * BM + wr * 64 + fr, col0 = ct * 256 + wc * 32 + 8 * fq;
#pragma unroll
        for (int ai = 0; ai < 2; ++ai)
#pragma unroll
            for (int m = 0; m < 4; ++m) { bf16_t* rowp = base + (size_t)(row0 + ai * HALF + m * 16) * ld + col0;
#pragma unroll
                for (int bj = 0; bj < 2; ++bj) { const f32x4 v0 = acc[ai][bj][m][0], v1 = acc[ai][bj][m][1];
                    u32x4 w; w.x = cvt_pk_bf16(v0[0], v0[1]); w.y = cvt_pk_bf16(v0[2], v0[3]); w.z = cvt_pk_bf16(v1[0], v1[1]); w.w = cvt_pk_bf16(v1[2], v1[3]);
                    *(u32x4*)(rowp + bj * HALF) = w; } }
    }
};

struct MapOrder {
    StaticOrder S; int f8;
    __device__ bool next(int i, Unit& u) const { if (!S.next(i, u)) return false; u.pn = f8 ? (u.pn < 3 ? u.pn : u.pn + 4) : u.pn + 3; return true; }
    __device__ __forceinline__ void a_ready(const Unit&) const {}
    __device__ __forceinline__ void done(const Unit&) const {}
};
struct EpiProj8 {
    static constexpr bool PERM = true, AFTER_DRAIN = false;
    unsigned char* ws; unsigned char* gt;
    __device__ __forceinline__ void operator()(const f32x4 (&acc)[2][2][4][2], const Unit& u, int wr, int wc, int fr, int fq) const {
        const int j = u.pn; size_t off = 0; int ld, ct;
        if (j < 2) { off = WS_QA; ld = 512; ct = j; } else if (j < 3) { off = WS_KVA; ld = 256; ct = 0; } else if (j < 7) { off = WS_VR; ld = 1024; ct = j - 3; }
        else if (j < 11) { off = WS_GR; ld = 1024; ct = j - 7; } else if (j < 15) { off = WS_GA; ld = 1024; ct = j - 11; } else { ld = 1024; ct = j - 15; }
        bf16_t* base = j < 15 ? (bf16_t*)(ws + off) : (bf16_t*)gt;
        const int row0 = u.pm * BM + wr * 64 + fr, col0 = ct * 256 + wc * 32 + 8 * fq;
        constexpr float SC = 1.0f / 8192.0f;
        if (j >= 11) {
            unsigned char* b8 = (unsigned char*)base;
#pragma unroll
            for (int ai = 0; ai < 2; ++ai)
#pragma unroll
                for (int m = 0; m < 4; ++m) { unsigned char* rowp = b8 + (size_t)(row0 + ai * HALF + m * 16) * 1024 + col0;
#pragma unroll
                    for (int bj = 0; bj < 2; ++bj) { const f32x4 v0 = acc[ai][bj][m][0] * SC, v1 = acc[ai][bj][m][1] * SC;
                        int q0 = __builtin_amdgcn_cvt_pk_fp8_f32(v0[0], v0[1], 0, false); q0 = __builtin_amdgcn_cvt_pk_fp8_f32(v0[2], v0[3], q0, true);
                        int q1 = __builtin_amdgcn_cvt_pk_fp8_f32(v1[0], v1[1], 0, false); q1 = __builtin_amdgcn_cvt_pk_fp8_f32(v1[2], v1[3], q1, true);
                        *(u32x2*)(rowp + bj * HALF) = (u32x2){(unsigned)q0, (unsigned)q1}; } }
            return;
        }
#pragma unroll
        for (int ai = 0; ai < 2; ++ai)
#pragma unroll
            for (int m = 0; m < 4; ++m) { bf16_t* rowp = base + (size_t)(row0 + ai * HALF + m * 16) * ld + col0;
#pragma unroll
                for (int bj = 0; bj < 2; ++bj) { const f32x4 v0 = acc[ai][bj][m][0] * SC, v1 = acc[ai][bj][m][1] * SC;
                    u32x4 w; w.x = cvt_pk_bf16(v0[0], v0[1]); w.y = cvt_pk_bf16(v0[2], v0[3]); w.z = cvt_pk_bf16(v1[0], v1[1]); w.w = cvt_pk_bf16(v1[2], v1[3]);
                    *(u32x4*)(rowp + bj * HALF) = w; } }
    }
};

struct EpiProjI8 {
    static constexpr bool PERM = true, AFTER_DRAIN = false;
    unsigned char* ws; unsigned char* gt; const float* rs; const float* cs;
    __device__ __forceinline__ void operator()(const i32x4 (&acc)[2][2][4][2], const Unit& u, int wr, int wc, int fr, int fq) const {
        const int pn = u.pn; size_t off = 0; int ld, ct;
        if (pn < 2) { off = WS_QA; ld = 512; ct = pn; } else if (pn < 3) { off = WS_KVA; ld = 256; ct = 0; } else if (pn < 5) { off = WS_QR; ld = 512; ct = pn - 3; }
        else if (pn < 7) { off = WS_KR; ld = 512; ct = pn - 5; } else if (pn < 11) { off = WS_VR; ld = 1024; ct = pn - 7; } else if (pn < 15) { off = WS_GR; ld = 1024; ct = pn - 11; }
        else if (pn < 19) { off = WS_GA; ld = 1024; ct = pn - 15; } else { ld = 1024; ct = pn - 19; }
        unsigned char* base = pn < 19 ? ws + off : gt;
        const int row0 = u.pm * BM + wr * 64 + fr, col0 = ct * 256 + wc * 32 + 8 * fq;
        f32x4 c4[2][2];
        { const float* cp = cs + pn * 256 + wc * 32 + 8 * fq;
#pragma unroll
          for (int bj = 0; bj < 2; ++bj) { c4[bj][0] = *(const f32x4*)(cp + bj * HALF); c4[bj][1] = *(const f32x4*)(cp + bj * HALF + 4); } }
#pragma unroll
        for (int ai = 0; ai < 2; ++ai)
#pragma unroll
            for (int m = 0; m < 4; ++m) { const int row = row0 + ai * HALF + m * 16; const float r = rs[row];
#pragma unroll
                for (int bj = 0; bj < 2; ++bj) {
                    const i32x4 a0 = acc[ai][bj][m][0], a1 = acc[ai][bj][m][1];
                    const f32x4 v0 = (f32x4){(float)a0[0], (float)a0[1], (float)a0[2], (float)a0[3]} * (c4[bj][0] * r), v1 = (f32x4){(float)a1[0], (float)a1[1], (float)a1[2], (float)a1[3]} * (c4[bj][1] * r);
                    if (pn >= 15) {
                        int q0 = __builtin_amdgcn_cvt_pk_fp8_f32(v0[0], v0[1], 0, false); q0 = __builtin_amdgcn_cvt_pk_fp8_f32(v0[2], v0[3], q0, true);
                        int q1 = __builtin_amdgcn_cvt_pk_fp8_f32(v1[0], v1[1], 0, false); q1 = __builtin_amdgcn_cvt_pk_fp8_f32(v1[2], v1[3], q1, true);
                        *(u32x2*)(base + (size_t)row * 1024 + col0 + bj * HALF) = (u32x2){(unsigned)q0, (unsigned)q1};
                    } else {
                        u32x4 w; w.x = cvt_pk_bf16(v0[0], v0[1]); w.y = cvt_pk_bf16(v0[2], v0[3]); w.z = cvt_pk_bf16(v1[0], v1[1]); w.w = cvt_pk_bf16(v1[2], v1[3]);
                        *(u32x4*)((bf16_t*)base + (size_t)row * ld + col0 + bj * HALF) = w; } } }
    }
};
struct EpiPlain {
    static constexpr bool PERM = true, AFTER_DRAIN = false;
    bf16_t* O; int ldc;
    __device__ __forceinline__ void operator()(const f32x4 (&acc)[2][2][4][2], const Unit& u, int wr, int wc, int fr, int fq) const {
        const int row0 = u.pm * BM + wr * 64 + fr, col0 = u.pn * BM + wc * 32 + 8 * fq;
#pragma unroll
        for (int ai = 0; ai < 2; ++ai)
#pragma unroll
            for (int m = 0; m < 4; ++m) { bf16_t* rowp = O + (size_t)(row0 + ai * HALF + m * 16) * ldc + col0;
#pragma unroll
                for (int bj = 0; bj < 2; ++bj) { const f32x4 v0 = acc[ai][bj][m][0], v1 = acc[ai][bj][m][1];
                    u32x4 w; w.x = cvt_pk_bf16(v0[0], v0[1]); w.y = cvt_pk_bf16(v0[2], v0[3]); w.z = cvt_pk_bf16(v1[0], v1[1]); w.w = cvt_pk_bf16(v1[2], v1[3]);
                    *(u32x4*)(rowp + bj * HALF) = w; } }
    }
};
template <int MODE> struct EpiGate {
    static constexpr bool PERM = true, AFTER_DRAIN = false;
    const bf16_t* G; const bf16_t* Y; bf16_t* O;
    __device__ __forceinline__ void operator()(const f32x4 (&acc)[2][2][4][2], const Unit& u, int wr, int wc, int fr, int fq) const {
        const int row0 = u.pm * BM + wr * 64 + fr, col0 = u.pn * BM + wc * 32 + 8 * fq;
#pragma unroll
        for (int ai = 0; ai < 2; ++ai)
#pragma unroll
            for (int m = 0; m < 4; ++m) { const size_t ro = (size_t)(row0 + ai * HALF + m * 16) * 1024 + col0;
#pragma unroll
                for (int bj = 0; bj < 2; ++bj) { const f32x4 v0 = acc[ai][bj][m][0], v1 = acc[ai][bj][m][1];
                    const u32x4 g = *(const u32x4*)(G + ro + bj * HALF);
                    float r0 = sigm(bflo(g.x)) * v0[0], r1 = sigm(bfhi(g.x)) * v0[1], r2 = sigm(bflo(g.y)) * v0[2], r3 = sigm(bfhi(g.y)) * v0[3];
                    float r4 = sigm(bflo(g.z)) * v1[0], r5 = sigm(bfhi(g.z)) * v1[1], r6 = sigm(bflo(g.w)) * v1[2], r7 = sigm(bfhi(g.w)) * v1[3];
                    if (MODE == 1) { const u32x4 y = *(const u32x4*)(Y + ro + bj * HALF);
                        r0 += bflo(y.x); r1 += bfhi(y.x); r2 += bflo(y.y); r3 += bfhi(y.y); r4 += bflo(y.z); r5 += bfhi(y.z); r6 += bflo(y.w); r7 += bfhi(y.w); }
                    u32x4 w; w.x = cvt_pk_bf16(r0, r1); w.y = cvt_pk_bf16(r2, r3); w.z = cvt_pk_bf16(r4, r5); w.w = cvt_pk_bf16(r6, r7);
                    *(u32x4*)(O + ro + bj * HALF) = w; } }
    }
};
struct EpiResid {
    static constexpr bool PERM = false, AFTER_DRAIN = false;
    const float* x; float* h;
    __device__ __forceinline__ void operator()(const f32x4 (&acc)[2][2][4][2], const Unit& u, int wr, int wc, int fr, int fq) const {
        const int col0 = u.pn * BM + wc * 32 + 4 * fq;
#pragma unroll
        for (int ai = 0; ai < 2; ++ai)
#pragma unroll
            for (int m = 0; m < 4; ++m) { const size_t off = (size_t)(u.pm * BM + ai * HALF + wr * 64 + m * 16 + fr) * 1024 + col0;
#pragma unroll
                for (int bj = 0; bj < 2; ++bj)
#pragma unroll
                    for (int n = 0; n < 2; ++n) *(f32x4*)(h + off + bj * HALF + n * 16) = *(const f32x4*)(x + off + bj * HALF + n * 16) + acc[ai][bj][m][n]; }
    }
};
struct EpiResid2 {
    static constexpr bool PERM = false, AFTER_DRAIN = false;
    const float* x; float* h; bf16_t* hg; const float* gain; float* ss;
    __device__ __forceinline__ void operator()(const f32x4 (&acc)[2][2][4][2], const Unit& u, int wr, int wc, int fr, int fq) const {
        const int col0 = u.pn * BM + wc * 32 + 4 * fq;
        f32x4 gv[2][2];
#pragma unroll
        for (int bj = 0; bj < 2; ++bj)
#pragma unroll
            for (int n = 0; n < 2; ++n) gv[bj][n] = *(const f32x4*)(gain + col0 + bj * HALF + n * 16);
#pragma unroll
        for (int ai = 0; ai < 2; ++ai)
#pragma unroll
            for (int m = 0; m < 4; ++m) { const int row = u.pm * BM + ai * HALF + wr * 64 + m * 16 + fr; const size_t off = (size_t)row * 1024 + col0; float sq = 0.f;
#pragma unroll
                for (int bj = 0; bj < 2; ++bj)
#pragma unroll
                    for (int n = 0; n < 2; ++n) { const f32x4 hv = *(const f32x4*)(x + off + bj * HALF + n * 16) + acc[ai][bj][m][n];
                        sq += (hv[0] * hv[0] + hv[1] * hv[1]) + (hv[2] * hv[2] + hv[3] * hv[3]);
                        const f32x4 t = hv * gv[bj][n]; u32x2 w; w.x = cvt_pk_bf16(t[0], t[1]); w.y = cvt_pk_bf16(t[2], t[3]); *(u32x2*)(hg + off + bj * HALF + n * 16) = w; }
                sq += __shfl_xor(sq, 16); sq += __shfl_xor(sq, 32);
                if (fq == 0) atomicAdd(ss + row, sq); }
    }
};
struct EpiResid2F8 {
    static constexpr bool PERM = false, AFTER_DRAIN = false;
    const float* x; float* h; bf16_t* hg; const float* gain; float* ss;
    __device__ __forceinline__ void operator()(const f32x4 (&acc)[2][2][4][2], const Unit& u, int wr, int wc, int fr, int fq) const {
        const int col0 = u.pn * BM + wc * 32 + 4 * fq;
        f32x4 gv[2][2];
#pragma unroll
        for (int bj = 0; bj < 2; ++bj)
#pragma unroll
            for (int n = 0; n < 2; ++n) gv[bj][n] = *(const f32x4*)(gain + col0 + bj * HALF + n * 16);
#pragma unroll
        for (int ai = 0; ai < 2; ++ai)
#pragma unroll
            for (int m = 0; m < 4; ++m) { const int row = u.pm * BM + ai * HALF + wr * 64 + m * 16 + fr; const size_t off = (size_t)row * 1024 + col0; float sq = 0.f;
#pragma unroll
                for (int bj = 0; bj < 2; ++bj)
#pragma unroll
                    for (int n = 0; n < 2; ++n) { const f32x4 hv = *(const f32x4*)(x + off + bj * HALF + n * 16) + acc[ai][bj][m][n] * (1.0f / 8192.0f);
                        sq += (hv[0] * hv[0] + hv[1] * hv[1]) + (hv[2] * hv[2] + hv[3] * hv[3]);
                        const f32x4 t = hv * gv[bj][n]; u32x2 w; w.x = cvt_pk_bf16(t[0], t[1]); w.y = cvt_pk_bf16(t[2], t[3]); *(u32x2*)(hg + off + bj * HALF + n * 16) = w; }
                sq += __shfl_xor(sq, 16); sq += __shfl_xor(sq, 32);
                if (fq == 0) atomicAdd(ss + row, sq); }
    }
};
struct EpiRowScale {
    static constexpr bool PERM = true, AFTER_DRAIN = false;
    bf16_t* O; int ldc; const float* ss;
    __device__ __forceinline__ void operator()(const f32x4 (&acc)[2][2][4][2], const Unit& u, int wr, int wc, int fr, int fq) const {
        const int row0 = u.pm * BM + wr * 64 + fr, col0 = u.pn * BM + wc * 32 + 8 * fq;
#pragma unroll
        for (int ai = 0; ai < 2; ++ai)
#pragma unroll
            for (int m = 0; m < 4; ++m) { const int row = row0 + ai * HALF + m * 16; bf16_t* rowp = O + (size_t)row * ldc + col0;
                const float rs = 1.0f / sqrtf(ss[row] * (1.0f / 1024.0f) + 1e-6f);
#pragma unroll
                for (int bj = 0; bj < 2; ++bj) { const f32x4 v0 = acc[ai][bj][m][0] * rs, v1 = acc[ai][bj][m][1] * rs;
                    u32x4 w; w.x = cvt_pk_bf16(v0[0], v0[1]); w.y = cvt_pk_bf16(v0[2], v0[3]); w.z = cvt_pk_bf16(v1[0], v1[1]); w.w = cvt_pk_bf16(v1[2], v1[3]);
                    *(u32x4*)(rowp + bj * HALF) = w; } }
    }
};
}
namespace pg8 {
struct Gemm2 { const bf16_t* A0; const bf16_t* B0t; int K0; const bf16_t* A1; const bf16_t* B1t; int K1; int ld; int M, N; };
struct EpiMerge2 {
    const unsigned char* GA; const unsigned char* GR; unsigned char* O;
    static __device__ __forceinline__ f32x4 dec8(unsigned w) { const f32x2 lo = __builtin_amdgcn_cvt_pk_f32_fp8((int)w, false), hi = __builtin_amdgcn_cvt_pk_f32_fp8((int)w, true); return (f32x4){lo[0], lo[1], hi[0], hi[1]}; }
    __device__ __forceinline__ void mid(f32x4 (&acc)[2][2][4][2], const Unit& u, int wr, int wc, int fr, int fq) const {
        int row0 = u.pm * BM + wr * 64 + fr, col0 = u.pn * BM + wc * 32 + 8 * fq; asm volatile("" : "+v"(row0), "+v"(col0));
        u32x2 ga[2], gr[2], na[2], nr[2];
        { const size_t ro = (size_t)row0 * 1024 + col0; ga[0] = *(const u32x2*)(GA + ro); ga[1] = *(const u32x2*)(GA + ro + HALF); gr[0] = *(const u32x2*)(GR + ro); gr[1] = *(const u32x2*)(GR + ro + HALF); }
#pragma unroll
        for (int ai = 0; ai < 2; ++ai)
#pragma unroll
            for (int m = 0; m < 4; ++m) {
                if (ai * 4 + m < 7) { const int ai2 = (ai * 4 + m + 1) >> 2, m2 = (ai * 4 + m + 1) & 3; const size_t ro = (size_t)(row0 + ai2 * HALF + m2 * 16) * 1024 + col0;
                    na[0] = *(const u32x2*)(GA + ro); na[1] = *(const u32x2*)(GA + ro + HALF); nr[0] = *(const u32x2*)(GR + ro); nr[1] = *(const u32x2*)(GR + ro + HALF); }
#pragma unroll
                for (int bj = 0; bj < 2; ++bj) {
#pragma unroll
                    for (int n = 0; n < 2; ++n) {
                        const f32x4 r4 = dec8(gr[bj][n]), a4 = dec8(ga[bj][n]);
                        const f32x4 num = (f32x4){__expf(-r4[0]), __expf(-r4[1]), __expf(-r4[2]), __expf(-r4[3])} + 1.0f;
                        const f32x4 den = (f32x4){__expf(-a4[0]), __expf(-a4[1]), __expf(-a4[2]), __expf(-a4[3])} + 1.0f;
                        acc[ai][bj][m][n] = acc[ai][bj][m][n] * (num * (f32x4){__builtin_amdgcn_rcpf(den[0]), __builtin_amdgcn_rcpf(den[1]), __builtin_amdgcn_rcpf(den[2]), __builtin_amdgcn_rcpf(den[3])});
                        asm volatile("" : "+v"(acc[ai][bj][m][n])); } }
                asm volatile("" ::: "memory");
                ga[0] = na[0]; ga[1] = na[1]; gr[0] = nr[0]; gr[1] = nr[1]; }
    }
    __device__ __forceinline__ void fin(const f32x4 (&acc)[2][2][4][2], const Unit& u, int wr, int wc, int fr, int fq) const {
        int row0 = u.pm * BM + wr * 64 + fr, col0 = u.pn * BM + wc * 32 + 8 * fq; asm volatile("" : "+v"(row0), "+v"(col0));
#pragma unroll
        for (int ai = 0; ai < 2; ++ai)
#pragma unroll
            for (int m = 0; m < 4; ++m) { const size_t ro = (size_t)(row0 + ai * HALF + m * 16) * 1024 + col0;
#pragma unroll
                for (int bj = 0; bj < 2; ++bj) { const f32x4 v0 = acc[ai][bj][m][0], v1 = acc[ai][bj][m][1];
                    const u32x2 g = *(const u32x2*)(GR + ro + bj * HALF);
                    const f32x4 g0 = dec8(g.x), g1 = dec8(g.y);
                    int q0 = __builtin_amdgcn_cvt_pk_fp8_f32(sigm(g0[0]) * v0[0] * 16.f, sigm(g0[1]) * v0[1] * 16.f, 0, false); q0 = __builtin_amdgcn_cvt_pk_fp8_f32(sigm(g0[2]) * v0[2] * 16.f, sigm(g0[3]) * v0[3] * 16.f, q0, true);
                    int q1 = __builtin_amdgcn_cvt_pk_fp8_f32(sigm(g1[0]) * v1[0] * 16.f, sigm(g1[1]) * v1[1] * 16.f, 0, false); q1 = __builtin_amdgcn_cvt_pk_fp8_f32(sigm(g1[2]) * v1[2] * 16.f, sigm(g1[3]) * v1[3] * 16.f, q1, true);
                    *(u32x2*)(O + ro + bj * HALF) = (u32x2){(unsigned)q0, (unsigned)q1}; }
                asm volatile("" ::: "memory"); }
    }
};
template <class Epi>
__device__ __forceinline__ void gemm_phase2(PG8_LAS unsigned char* lds, const Gemm2 g, const StaticOrder& S, const Epi& E) {
    const int tid = threadIdx.x, wid = __builtin_amdgcn_readfirstlane(tid >> 6), lane = tid & 63, wr = wid >> 2, wc = wid & 3, fr = lane & 15, fq = lane >> 4;
    unsigned voffA[2], voffB[2];
#pragma unroll
    for (int i = 0; i < 2; ++i) { int R, C; stage_rc(tid * 16 + i * 8192, R, C); const int Rb = (R & ~31) + perm32(R & 31);
        voffA[i] = (unsigned)(R * g.ld + C) * 2u; voffB[i] = (unsigned)(Rb * g.ld + C) * 2u; }
    const size_t kstep = (size_t)(BK * 2);
    const size_t hstep = (size_t)HALF * g.ld * 2, tstep = 2 * hstep;
    const int nt0 = g.K0 / BK, nt1 = g.K1 / BK;
    const unsigned ldsw = (unsigned)wid * 1024u;
    const int aoff = lds_byte(wr * 64 + fr, fq * 8), boff = lds_byte(wc * 32 + fr, fq * 8);
#define PG8_SA(b, h) (((b) * 2 + (h)) * HTB)
#define PG8_SB(b, h) ((4 + (b) * 2 + (h)) * HTB)
#define PG8_STAGE(bufoff, gbase, voff) do { _Pragma("unroll") for (int _i = 0; _i < 2; ++_i) \
        __builtin_amdgcn_global_load_lds((const unsigned*)((const char*)(gbase) + (voff)[_i]), (PG8_LAS unsigned*)(lds + (bufoff) + ldsw + _i * 8192), 16, 0, 0); } while (0)
#define PG8_LDA(dst, b, h) do { _Pragma("unroll") for (int m = 0; m < 4; ++m) _Pragma("unroll") for (int k = 0; k < 2; ++k) dst[m][k] = *(const PG8_LAS bf16x8*)(lds + PG8_SA(b, h) + aoff + m * 2048 + k * 1024); } while (0)
#define PG8_LDB(dst, b, h) do { _Pragma("unroll") for (int n = 0; n < 2; ++n) _Pragma("unroll") for (int k = 0; k < 2; ++k) dst[n][k] = *(const PG8_LAS bf16x8*)(lds + PG8_SB(b, h) + boff + n * 2048 + k * 1024); } while (0)
#define PG8_MMA(ai, bj, At, Bt) do { __builtin_amdgcn_s_setprio(1); _Pragma("unroll") for (int m = 0; m < 4; ++m) _Pragma("unroll") for (int n = 0; n < 2; ++n) _Pragma("unroll") for (int k = 0; k < 2; ++k) \
        acc[ai][bj][m][n] = __builtin_amdgcn_mfma_f32_16x16x32_bf16(Bt[n][k], At[m][k], acc[ai][bj][m][n], 0, 0, 0); __builtin_amdgcn_s_setprio(0); } while (0)
#define PG8_WAIT_V(n) asm volatile("s_waitcnt vmcnt(" #n ")" ::: "memory")
#define PG8_WAIT_L(n) asm volatile("s_waitcnt lgkmcnt(" #n ")" ::: "memory")
#define PG8_BAR __builtin_amdgcn_s_barrier()
#define PG8_SCHED __builtin_amdgcn_sched_barrier(0)
    Unit cur, nxt;
    if (!S.next(0, cur)) return;
    f32x4 acc[2][2][4][2];
#pragma unroll
    for (int a = 0; a < 2; ++a)
#pragma unroll
        for (int b = 0; b < 2; ++b)
#pragma unroll
            for (int m = 0; m < 4; ++m)
#pragma unroll
                for (int n = 0; n < 2; ++n) acc[a][b][m][n] = (f32x4){0.f, 0.f, 0.f, 0.f};
    bf16x8 At[4][2], B0[2][2], B1[2][2];
    const char* cA = (const char*)g.A0 + (size_t)cur.pm * tstep; const char* cB = (const char*)g.B0t + (size_t)cur.pn * tstep;
    PG8_STAGE(PG8_SB(0, 0), cB, voffB); PG8_STAGE(PG8_SB(0, 1), cB + hstep, voffB); PG8_STAGE(PG8_SA(0, 0), cA, voffA); PG8_STAGE(PG8_SA(0, 1), cA + hstep, voffA);
    if (wr == 1) PG8_BAR;
    PG8_WAIT_V(2); PG8_BAR;
    PG8_STAGE(PG8_SB(1, 0), cB + kstep, voffB); PG8_STAGE(PG8_SA(1, 0), cA + kstep, voffA); PG8_STAGE(PG8_SB(1, 1), cB + hstep + kstep, voffB);
    PG8_WAIT_V(6); PG8_BAR;
#define PG8_KLOOP(NT) do { for (int t = 0; t < (NT); t += 2) { \
            const bool last = (t == (NT) - 2); \
            const char* a1 = cA + (size_t)(t + 1) * kstep; \
            const char* a2 = last ? nA : cA + (size_t)(t + 2) * kstep; const char* b2 = last ? nB : cB + (size_t)(t + 2) * kstep; \
            const char* a3 = a2 + kstep; const char* b3 = b2 + kstep; \
            PG8_LDB(B0, 0, 0); PG8_LDB(B1, 0, 1); PG8_SCHED; PG8_LDA(At, 0, 0); PG8_STAGE(PG8_SA(1, 1), a1 + hstep, voffA); \
            PG8_WAIT_V(8); PG8_WAIT_L(0); PG8_BAR; PG8_MMA(0, 0, At, B0); PG8_MMA(0, 1, At, B1); PG8_BAR; PG8_SCHED; \
            PG8_LDA(At, 0, 1); PG8_STAGE(PG8_SB(0, 0), b2, voffB); PG8_STAGE(PG8_SB(0, 1), b2 + hstep, voffB); PG8_STAGE(PG8_SA(0, 0), a2, voffA); \
            PG8_WAIT_V(8); PG8_WAIT_L(0); PG8_BAR; PG8_MMA(1, 0, At, B0); PG8_MMA(1, 1, At, B1); PG8_BAR; PG8_SCHED; \
            PG8_LDB(B0, 1, 0); PG8_LDB(B1, 1, 1); PG8_SCHED; PG8_LDA(At, 1, 0); PG8_STAGE(PG8_SA(0, 1), a2 + hstep, voffA); \
            PG8_WAIT_V(8); PG8_WAIT_L(0); PG8_BAR; PG8_MMA(0, 0, At, B0); PG8_MMA(0, 1, At, B1); PG8_BAR; PG8_SCHED; \
            PG8_LDA(At, 1, 1); PG8_STAGE(PG8_SB(1, 0), b3, voffB); PG8_STAGE(PG8_SB(1, 1), b3 + hstep, voffB); PG8_STAGE(PG8_SA(1, 0), a3, voffA); \
            PG8_WAIT_V(8); PG8_WAIT_L(0); PG8_BAR; PG8_MMA(1, 0, At, B0); PG8_MMA(1, 1, At, B1); PG8_BAR; PG8_SCHED; } } while (0)
    int ti = 0;
    for (;;) {
        const char* nA = (const char*)g.A1 + (size_t)cur.pm * tstep; const char* nB = (const char*)g.B1t + (size_t)cur.pn * tstep;
        PG8_KLOOP(nt0);
        if (wr == 0) PG8_BAR;
        PG8_SCHED; E.mid(acc, cur, wr, wc, fr, fq); PG8_SCHED;
        cA = nA; cB = nB;
        if (wr == 1) PG8_BAR;
        const bool has_next = S.next(ti + 1, nxt);
        nA = has_next ? (const char*)g.A0 + (size_t)nxt.pm * tstep : cA; nB = has_next ? (const char*)g.B0t + (size_t)nxt.pn * tstep : cB;
        PG8_KLOOP(nt1);
        if (wr == 0) PG8_BAR;
        PG8_SCHED; E.fin(acc, cur, wr, wc, fr, fq); PG8_SCHED;
        if (!has_next) break;
#pragma unroll
        for (int a = 0; a < 2; ++a)
#pragma unroll
            for (int b = 0; b < 2; ++b)
#pragma unroll
                for (int m = 0; m < 4; ++m)
#pragma unroll
                    for (int n = 0; n < 2; ++n) acc[a][b][m][n] = (f32x4){0.f, 0.f, 0.f, 0.f};
        cur = nxt; cA = nA; cB = nB; ++ti;
        if (wr == 1) PG8_BAR;
    }
#undef PG8_KLOOP
    PG8_WAIT_V(0);
    PG8_BAR;
#undef PG8_SA
#undef PG8_SB
#undef PG8_STAGE
#undef PG8_LDA
#undef PG8_LDB
#undef PG8_MMA
#undef PG8_WAIT_V
#undef PG8_WAIT_L
#undef PG8_BAR
#undef PG8_SCHED
}
}

#define GAS __attribute__((address_space(1)))
#define LAS __attribute__((address_space(3)))
typedef unsigned short bf16;
typedef unsigned v4u __attribute__((ext_vector_type(4)));
typedef float f32x4 __attribute__((ext_vector_type(4)));
typedef short bf16x8 __attribute__((ext_vector_type(8)));
typedef GAS unsigned gu32;
typedef GAS unsigned long long gu64;
#define RLX_AGENT __ATOMIC_RELAXED, __HIP_MEMORY_SCOPE_AGENT
#define LDS_WAIT() asm volatile("s_waitcnt lgkmcnt(0)" ::: "memory")
#define VM_WAIT() asm volatile("s_waitcnt vmcnt(0)" ::: "memory")
__device__ __forceinline__ unsigned long long rt() { return __builtin_amdgcn_s_memrealtime(); }
__device__ __forceinline__ unsigned f2bf(float f) { unsigned u = __builtin_bit_cast(unsigned, f); return (u + 0x7fffu + ((u >> 16) & 1u)) >> 16; }
__device__ __forceinline__ unsigned pk2(float lo, float hi) { return f2bf(lo) | (f2bf(hi) << 16); }
#define XB_TMO      128
#define XB_XCNT(j)  (256  + 64 * (j))
#define XB_XSUB(j)  (1280 + 64 * (j))
#define XB_XGEN(j)  (2304 + 64 * (j))
#define XB_TOP      3328
#define XB_TOPGEN   3392
#define XCD_BAR_WORDS 3456
#define XB_SPIN_CAP (1u << 18)

__device__ __forceinline__ unsigned xb_ld(unsigned* p)              { return __hip_atomic_load(p, __ATOMIC_RELAXED, __HIP_MEMORY_SCOPE_AGENT); }
__device__ __forceinline__ unsigned xb_add(unsigned* p, unsigned v) { return __hip_atomic_fetch_add(p, v, __ATOMIC_RELAXED, __HIP_MEMORY_SCOPE_AGENT); }
__device__ __forceinline__ unsigned xb_xcc_id() { return (unsigned)__builtin_amdgcn_s_getreg((3 << 11) | 20) & 0xFu; }
#define XB_SPIN(cond, bar) do { unsigned _sp = 0; while (cond) { __builtin_amdgcn_s_sleep(1); \
    if ((++_sp & 255u) == 0u) { if (xb_ld(&(bar)[XB_TMO])) break; if (_sp > XB_SPIN_CAP) { atomicAdd(&(bar)[XB_TMO], 1u); break; } } } } while (0)

struct XcdBarrier {
    unsigned* bar; unsigned x;
    volatile LAS unsigned* st;
};

__device__ __forceinline__ XcdBarrier xcd_barrier_post(unsigned* bar, volatile LAS unsigned* st) {
    XcdBarrier b; b.bar = bar; b.x = xb_xcc_id(); b.st = st;
    if (threadIdx.x == 0) (void)xb_add(&bar[XB_XCNT(b.x)], 1u);
    return b;
}
__device__ __forceinline__ void xcd_barrier_complete(unsigned* bar, unsigned x, unsigned& nloc, unsigned& nx) {
    const unsigned G = gridDim.x * gridDim.y * gridDim.z;
    unsigned sum, cnt, mine, sp = 0u;
    for (;;) {
        sum = 0u; cnt = 0u; mine = 0u;
#pragma unroll
        for (unsigned j = 0; j < 16; ++j) { const unsigned c = xb_ld(&bar[XB_XCNT(j)]); sum += c; cnt += (c > 0u) ? 1u : 0u; mine = (j == x) ? c : mine; }
        if (sum == G) break;
        __builtin_amdgcn_s_sleep(1);
        if ((++sp & 255u) == 0u) { if (xb_ld(&bar[XB_TMO])) break; if (sp > XB_SPIN_CAP) { atomicAdd(&bar[XB_TMO], 1u); break; } }
    }
    nloc = mine > 0u ? mine : 1u; nx = cnt > 0u ? cnt : 1u;
}

__device__ __forceinline__ void xcd_barrier(const XcdBarrier& b) {
    asm volatile("s_waitcnt vmcnt(0)" ::: "memory");
    __syncthreads();
    if (threadIdx.x == 0) {
        unsigned* bar = b.bar;
        __builtin_amdgcn_s_waitcnt(0);
        unsigned nloc = b.st[0], nx = b.st[1];
        if (nloc == 0u) { xcd_barrier_complete(bar, b.x, nloc, nx); b.st[0] = nloc; b.st[1] = nx; }
        const unsigned old = xb_add(&bar[XB_XSUB(b.x)], 1u);
        const unsigned gen = old / nloc;
        if (old + 1u == (gen + 1u) * nloc) {
            __builtin_amdgcn_fence(__ATOMIC_RELEASE, "agent");
            asm volatile("s_waitcnt vmcnt(0)" ::: "memory");
            const unsigned og = xb_add(&bar[XB_TOP], 1u);
            const unsigned tg = og / nx;
            if (og + 1u == (tg + 1u) * nx) xb_add(&bar[XB_TOPGEN], 1u);
            else XB_SPIN(xb_ld(&bar[XB_TOPGEN]) == tg, bar);
            __builtin_amdgcn_fence(__ATOMIC_ACQUIRE, "agent");
            xb_add(&bar[XB_XGEN(b.x)], 1u);
            asm volatile("s_waitcnt vmcnt(0)" ::: "memory");
        } else {
            XB_SPIN(xb_ld(&bar[XB_XGEN(b.x)]) == gen, bar);
            __builtin_amdgcn_fence(__ATOMIC_ACQUIRE, "agent");
            asm volatile("s_waitcnt vmcnt(0)" ::: "memory");
        }
    }
    __syncthreads();
}
constexpr int NWAVES = 8, NTHR = 512;
constexpr int RING_OFF = 0, RING_BYTES = 131072;
constexpr int LDSCTL_OFF = RING_BYTES, MISC_OFF = LDSCTL_OFF + 320;
constexpr int LDS_BYTES = 147456;
struct Args { const float* in[14]; float* out; unsigned char* ws; int ph_lo, ph_hi; };

typedef unsigned v2u __attribute__((ext_vector_type(2)));
__device__ __forceinline__ float bfl(unsigned w) { return __builtin_bit_cast(float, w << 16); }
__device__ __forceinline__ float bfh(unsigned w) { return __builtin_bit_cast(float, w & 0xffff0000u); }
__device__ __forceinline__ float bf2f(unsigned h) { return __builtin_bit_cast(float, h << 16); }
__device__ __forceinline__ float wave_sum(float v) {
#pragma unroll
    for (int o = 1; o < 64; o <<= 1) v += __shfl_xor(v, o);
    return v;
}

__device__ __forceinline__ void p0_transpose_item(const float* W, int K, int N, bf16* WT, LAS float* scr, int item, int lane, int pitch = 0, unsigned char* WT8 = nullptr) {
    if (pitch == 0) pitch = K;
    const int nblk = N / 32, kb = item / nblk, nb = item % nblk, k0 = 64 * kb, n0 = 32 * nb;
#pragma unroll 8
    for (int i = 0; i < 32; ++i) { const int kk = 2 * i + (lane >> 5); scr[kk * 33 + (lane & 31)] = W[(size_t)(k0 + kk) * N + n0 + (lane & 31)]; }
    LDS_WAIT(); asm volatile("" ::: "memory");
    const int c = lane & 7;
    if (WT8) {
#pragma unroll
        for (int j = 0; j < 4; ++j) { const int n = (lane >> 3) + 8 * j; const LAS float* s = scr + (8 * c) * 33 + n;
            int q0 = __builtin_amdgcn_cvt_pk_fp8_f32(s[0 * 33] * 512.f, s[1 * 33] * 512.f, 0, false); q0 = __builtin_amdgcn_cvt_pk_fp8_f32(s[2 * 33] * 512.f, s[3 * 33] * 512.f, q0, true);
            int q1 = __builtin_amdgcn_cvt_pk_fp8_f32(s[4 * 33] * 512.f, s[5 * 33] * 512.f, 0, false); q1 = __builtin_amdgcn_cvt_pk_fp8_f32(s[6 * 33] * 512.f, s[7 * 33] * 512.f, q1, true);
            *(GAS v2u*)(WT8 + (size_t)(n0 + n) * K + k0 + 8 * c) = (v2u){(unsigned)q0, (unsigned)q1}; }
        LDS_WAIT(); asm volatile("" ::: "memory");
        return;
    }
#pragma unroll
    for (int j = 0; j < 4; ++j) { const int n = (lane >> 3) + 8 * j; const LAS float* s = scr + (8 * c) * 33 + n;
        v4u o; o.x = pk2(s[0 * 33], s[1 * 33]); o.y = pk2(s[2 * 33], s[3 * 33]); o.z = pk2(s[4 * 33], s[5 * 33]); o.w = pk2(s[6 * 33], s[7 * 33]);
        *(GAS v4u*)(WT + (size_t)(n0 + n) * pitch + k0 + 8 * c) = o; }
    LDS_WAIT(); asm volatile("" ::: "memory");
}

__device__ __forceinline__ void p0_win_i8(const float* W, unsigned char* W8, float* csc, LAS float* red, int wg, int nwg) {
    const int tid = threadIdx.x, c = tid & 31, r8 = tid >> 5;
    for (int blk = wg; blk * 23 < INW; blk += nwg) {
        const int n = blk * 23 + c; const bool act = c < 23;
        float w[64]; float mx = 0.f;
        if (act) {
            const GAS float* wp = (const GAS float*)W + (size_t)(64 * r8) * INW + n;
#pragma unroll
            for (int j = 0; j < 64; ++j) w[j] = wp[(size_t)j * INW];
#pragma unroll
            for (int j = 0; j < 64; ++j) mx = fmaxf(mx, fabsf(w[j]));
        }
        __syncthreads();
        red[r8 * 32 + c] = mx;
        __syncthreads();
#pragma unroll
        for (int j = 0; j < 16; ++j) mx = fmaxf(mx, red[j * 32 + c]);
        if (act) {
            const float qs = mx > 0.f ? 127.0f / mx : 0.f;
            if (r8 == 0) csc[n] = mx * (1.0f / 127.0f);
            GAS v4u* op = (GAS v4u*)(W8 + (size_t)n * DM + 64 * r8);
#pragma unroll
            for (int q = 0; q < 4; ++q) { unsigned d[4];
#pragma unroll
                for (int e = 0; e < 4; ++e) { const int b0 = (int)rintf(w[16 * q + 4 * e] * qs), b1 = (int)rintf(w[16 * q + 4 * e + 1] * qs), b2 = (int)rintf(w[16 * q + 4 * e + 2] * qs), b3 = (int)rintf(w[16 * q + 4 * e + 3] * qs);
                    d[e] = (unsigned)(b0 & 255) | ((unsigned)(b1 & 255) << 8) | ((unsigned)(b2 & 255) << 16) | ((unsigned)b3 << 24); }
                op[q] = (v4u){d[0], d[1], d[2], d[3]}; }
        }
    }
    __syncthreads();
}
__device__ __forceinline__ void rms_row_to_bf16(const float* xrow, const float* gain, bf16* orow, unsigned* o8row, float* rsc, int lane) {
    const GAS f32x4* xr = (const GAS f32x4*)xrow + lane;
    f32x4 v[4]; float s = 0.f;
#pragma unroll
    for (int j = 0; j < 4; ++j) { v[j] = xr[64 * j]; s += (v[j].x * v[j].x + v[j].y * v[j].y) + (v[j].z * v[j].z + v[j].w * v[j].w); }
    const float rstd = 1.f / sqrtf(wave_sum(s) * (1.f / DM) + EPS);
#pragma unroll
    for (int j = 0; j < 4; ++j) { const f32x4 g = ((const GAS f32x4*)gain)[lane + 64 * j];
        v[j] = (f32x4){v[j].x * rstd * g.x, v[j].y * rstd * g.y, v[j].z * rstd * g.z, v[j].w * rstd * g.w}; }
    float mx = 0.f;
#pragma unroll
    for (int j = 0; j < 4; ++j) mx = fmaxf(fmaxf(mx, fmaxf(fabsf(v[j].x), fabsf(v[j].y))), fmaxf(fabsf(v[j].z), fabsf(v[j].w)));
#pragma unroll
    for (int o = 1; o < 64; o <<= 1) mx = fmaxf(mx, __shfl_xor(mx, o));
    const float qs = mx > 0.f ? 127.0f / mx : 0.f;
#pragma unroll
    for (int j = 0; j < 4; ++j) {
        const int q0 = (int)rintf(v[j].x * qs), q1 = (int)rintf(v[j].y * qs), q2 = (int)rintf(v[j].z * qs), q3 = (int)rintf(v[j].w * qs);
        ((GAS unsigned*)o8row)[lane + 64 * j] = (unsigned)(q0 & 255) | ((unsigned)(q1 & 255) << 8) | ((unsigned)(q2 & 255) << 16) | ((unsigned)q3 << 24); }
    if (lane == 0) *rsc = mx * (1.0f / 127.0f);
}
__device__ __forceinline__ void p_tables(float* tab, int gtid, int gthreads) {
    float* cosA = tab, *sinA = tab + 2048 * 8, *cosR = tab + 2048 * 16, *sinR = tab + 2048 * 16 + 2048 * 32;
    for (int i = gtid; i < 2048 * 40; i += gthreads) {
        const int pos = i / 40, f = i % 40;
        if (f < 8) { const float inv = (float)pow(500000.0, -(double)f / 8.0); const float ang = (float)pos * inv;
            cosA[pos * 8 + f] = (float)cos((double)ang); sinA[pos * 8 + f] = (float)sin((double)ang); }
        else { const int g = f - 8; const float inv = (float)pow(10000.0, -(double)g / 32.0); const float ang = (float)pos * inv;
            cosR[pos * 32 + g] = (float)cos((double)ang); sinR[pos * 32 + g] = (float)sin((double)ang); }
    }
}

typedef __bf16 bf16x2_t __attribute__((ext_vector_type(2)));
template <int CTRL> __device__ __forceinline__ float dpp_f(float v) { return __builtin_bit_cast(float, __builtin_amdgcn_update_dpp(0, __builtin_bit_cast(int, v), CTRL, 0xf, 0xf, false)); }

typedef float f32x2_t __attribute__((ext_vector_type(2)));

__device__ __forceinline__ void row_to_fp4(const float* xrow, unsigned char* o4, float* scale_out, int lane) {
    const GAS f32x4* xr = (const GAS f32x4*)xrow + lane;
    f32x4 v[4]; float mx = 0.f;
#pragma unroll
    for (int j = 0; j < 4; ++j) { v[j] = xr[64 * j]; mx = fmaxf(fmaxf(mx, fmaxf(fabsf(v[j].x), fabsf(v[j].y))), fmaxf(fabsf(v[j].z), fabsf(v[j].w))); }
#pragma unroll
    for (int o = 1; o < 64; o <<= 1) mx = fmaxf(mx, __shfl_xor(mx, o));
    const float sc = mx > 0.f ? mx * (1.0f / 6.0f) : 1.0f, inv = 1.0f / sc;
    unsigned w0 = 0u, w1 = 0u;
    w0 = __builtin_amdgcn_cvt_scalef32_pk_fp4_f32(w0, v[0].x * inv, v[0].y * inv, 1.0f, 0); w0 = __builtin_amdgcn_cvt_scalef32_pk_fp4_f32(w0, v[0].z * inv, v[0].w * inv, 1.0f, 1);
    w0 = __builtin_amdgcn_cvt_scalef32_pk_fp4_f32(w0, v[1].x * inv, v[1].y * inv, 1.0f, 2); w0 = __builtin_amdgcn_cvt_scalef32_pk_fp4_f32(w0, v[1].z * inv, v[1].w * inv, 1.0f, 3);
    w1 = __builtin_amdgcn_cvt_scalef32_pk_fp4_f32(w1, v[2].x * inv, v[2].y * inv, 1.0f, 0); w1 = __builtin_amdgcn_cvt_scalef32_pk_fp4_f32(w1, v[2].z * inv, v[2].w * inv, 1.0f, 1);
    w1 = __builtin_amdgcn_cvt_scalef32_pk_fp4_f32(w1, v[3].x * inv, v[3].y * inv, 1.0f, 2); w1 = __builtin_amdgcn_cvt_scalef32_pk_fp4_f32(w1, v[3].z * inv, v[3].w * inv, 1.0f, 3);
    *(GAS unsigned long long*)(o4 + 8 * lane) = (unsigned long long)w0 | ((unsigned long long)w1 << 32);
    if (lane == 0) *scale_out = sc;
}
template <int NR> __device__ __forceinline__ void rows_to_fp4(const float* const (&xrow)[NR], unsigned char* const (&o4)[NR], float* const (&sco)[NR], int lane) {
    f32x4 v[NR][4];
#pragma unroll
    for (int r = 0; r < NR; ++r) { const GAS f32x4* xr = (const GAS f32x4*)xrow[r] + lane;
#pragma unroll
        for (int j = 0; j < 4; ++j) v[r][j] = xr[64 * j]; }
#pragma unroll
    for (int r = 0; r < NR; ++r) {
        float mx = 0.f;
#pragma unroll
        for (int j = 0; j < 4; ++j) mx = fmaxf(fmaxf(mx, fmaxf(fabsf(v[r][j].x), fabsf(v[r][j].y))), fmaxf(fabsf(v[r][j].z), fabsf(v[r][j].w)));
#pragma unroll
        for (int o = 1; o < 64; o <<= 1) mx = fmaxf(mx, __shfl_xor(mx, o));
        const float sc = mx > 0.f ? mx * (1.0f / 6.0f) : 1.0f, inv = 1.0f / sc;
        unsigned w0 = 0u, w1 = 0u;
        w0 = __builtin_amdgcn_cvt_scalef32_pk_fp4_f32(w0, v[r][0].x * inv, v[r][0].y * inv, 1.0f, 0); w0 = __builtin_amdgcn_cvt_scalef32_pk_fp4_f32(w0, v[r][0].z * inv, v[r][0].w * inv, 1.0f, 1);
        w0 = __builtin_amdgcn_cvt_scalef32_pk_fp4_f32(w0, v[r][1].x * inv, v[r][1].y * inv, 1.0f, 2); w0 = __builtin_amdgcn_cvt_scalef32_pk_fp4_f32(w0, v[r][1].z * inv, v[r][1].w * inv, 1.0f, 3);
        w1 = __builtin_amdgcn_cvt_scalef32_pk_fp4_f32(w1, v[r][2].x * inv, v[r][2].y * inv, 1.0f, 0); w1 = __builtin_amdgcn_cvt_scalef32_pk_fp4_f32(w1, v[r][2].z * inv, v[r][2].w * inv, 1.0f, 1);
        w1 = __builtin_amdgcn_cvt_scalef32_pk_fp4_f32(w1, v[r][3].x * inv, v[r][3].y * inv, 1.0f, 2); w1 = __builtin_amdgcn_cvt_scalef32_pk_fp4_f32(w1, v[r][3].z * inv, v[r][3].w * inv, 1.0f, 3);
        *(GAS unsigned long long*)(o4[r] + 8 * lane) = (unsigned long long)w0 | ((unsigned long long)w1 << 32);
        if (lane == 0) *sco[r] = sc;
    }
}
__device__ __forceinline__ float gelu_as(float v) {
    const float av = fabsf(v), t = __builtin_amdgcn_rcpf(av * 0.2316418882f + 1.0f);
    float q = t * 0.5307027145f + (-0.7265760135f); q = q * t + 0.7107068705f; q = q * t + (-0.142248368f); q = q * t + 0.127414796f; q = q * t;
    const float e = __builtin_amdgcn_exp2f((v * v) * (-0.72134752044f));
    const float m = v * (q * e);
    return v < 0.f ? m : v - m;
}
struct PeerTabs { const unsigned char* U4; const unsigned char* V4; const float* SU; const float* SV; };
struct PeerBuf8 { unsigned u[8][2], v[8][2]; };
__device__ __forceinline__ void peer_load8(PeerBuf8& B, const PeerTabs& Tb, int i0, int i1, int hh, int lane) {
    int e[8];
#pragma unroll
    for (int j = 0; j < 8; ++j) { const int k = hh * 8 + j; e[j] = __builtin_amdgcn_readlane(k < 64 ? i0 : i1, k & 63); }
#pragma unroll
    for (int j = 0; j < 8; ++j) { const v2u t = *(const v2u*)(Tb.U4 + (size_t)e[j] * 1024 + 8 * lane); B.u[j][0] = t.x; B.u[j][1] = t.y; }
#pragma unroll
    for (int j = 0; j < 8; ++j) { const v2u t = *(const v2u*)(Tb.U4 + (size_t)e[j] * 1024 + 512 + 8 * lane); B.v[j][0] = t.x; B.v[j][1] = t.y; }
}
__device__ __forceinline__ void dec4(const unsigned (&w)[2], float (&f)[16]) {
#pragma unroll
    for (int dw = 0; dw < 2; ++dw) {
        const f32x2_t a = __builtin_amdgcn_cvt_scalef32_pk_f32_fp4(w[dw], 1.0f, 0), b = __builtin_amdgcn_cvt_scalef32_pk_f32_fp4(w[dw], 1.0f, 1);
        const f32x2_t c = __builtin_amdgcn_cvt_scalef32_pk_f32_fp4(w[dw], 1.0f, 2), d = __builtin_amdgcn_cvt_scalef32_pk_f32_fp4(w[dw], 1.0f, 3);
        f[8 * dw] = a.x; f[8 * dw + 1] = a.y; f[8 * dw + 2] = b.x; f[8 * dw + 3] = b.y; f[8 * dw + 4] = c.x; f[8 * dw + 5] = c.y; f[8 * dw + 6] = d.x; f[8 * dw + 7] = d.y;
    }
}
__device__ __forceinline__ float quad_reduce(const float (&p)[4]) {
    float q0, q1, r;
    { auto t = __builtin_amdgcn_permlane32_swap(__builtin_bit_cast(unsigned, p[0]), __builtin_bit_cast(unsigned, p[1]), false, false); const unsigned t0 = t[0], t1 = t[1]; q0 = __builtin_bit_cast(float, t0) + __builtin_bit_cast(float, t1); }
    { auto t = __builtin_amdgcn_permlane32_swap(__builtin_bit_cast(unsigned, p[2]), __builtin_bit_cast(unsigned, p[3]), false, false); const unsigned t0 = t[0], t1 = t[1]; q1 = __builtin_bit_cast(float, t0) + __builtin_bit_cast(float, t1); }
    { auto t = __builtin_amdgcn_permlane16_swap(__builtin_bit_cast(unsigned, q0), __builtin_bit_cast(unsigned, q1), false, false); const unsigned t0 = t[0], t1 = t[1]; r = __builtin_bit_cast(float, t0) + __builtin_bit_cast(float, t1); }
    r += dpp_f<0x128>(r); r += dpp_f<0x124>(r); r += dpp_f<0x122>(r); r += dpp_f<0x121>(r);
    return r;
}
__device__ __forceinline__ void peer_compute8(const PeerBuf8& B, const unsigned (&xw)[8], float xs, float gs0, float gs1, float su0, float su1, int hh, int lane, float (&acc)[16]) {
    float pa[4], pb[4];
#pragma unroll
    for (int j = 0; j < 8; ++j) { float s0 = 0.f, s1 = 0.f;
#pragma unroll
        for (int dw = 0; dw < 2; ++dw) {
            s0 = __builtin_amdgcn_fdot2_f32_bf16(__builtin_amdgcn_cvt_scalef32_pk_bf16_fp4(B.u[j][dw], 1.0f, 0), __builtin_bit_cast(bf16x2_t, xw[4 * dw + 0]), s0, false);
            s1 = __builtin_amdgcn_fdot2_f32_bf16(__builtin_amdgcn_cvt_scalef32_pk_bf16_fp4(B.u[j][dw], 1.0f, 1), __builtin_bit_cast(bf16x2_t, xw[4 * dw + 1]), s1, false);
            s0 = __builtin_amdgcn_fdot2_f32_bf16(__builtin_amdgcn_cvt_scalef32_pk_bf16_fp4(B.u[j][dw], 1.0f, 2), __builtin_bit_cast(bf16x2_t, xw[4 * dw + 2]), s0, false);
            s1 = __builtin_amdgcn_fdot2_f32_bf16(__builtin_amdgcn_cvt_scalef32_pk_bf16_fp4(B.u[j][dw], 1.0f, 3), __builtin_bit_cast(bf16x2_t, xw[4 * dw + 3]), s1, false); }
        if (j < 4) pa[j] = s0 + s1; else pb[j - 4] = s0 + s1; }
    const float ra = quad_reduce(pa), rb = quad_reduce(pb);
    const int row = lane >> 4, jj = ((row & 1) << 1) | (row >> 1), hi = (lane >> 3) & 1;
    const int k = hh * 8 + 4 * hi + jj;
    const float r = (hi ? rb : ra) * xs;
    const float gsel = __shfl(k < 64 ? gs0 : gs1, k & 63);
    const float su = __shfl(k < 64 ? su0 : su1, k & 63);
    const int coef = __builtin_bit_cast(int, gsel * gelu_as(r * su));
    const float c[8] = { __builtin_bit_cast(float, __builtin_amdgcn_readlane(coef, 0)), __builtin_bit_cast(float, __builtin_amdgcn_readlane(coef, 32)), __builtin_bit_cast(float, __builtin_amdgcn_readlane(coef, 16)), __builtin_bit_cast(float, __builtin_amdgcn_readlane(coef, 48)),
                         __builtin_bit_cast(float, __builtin_amdgcn_readlane(coef, 8)), __builtin_bit_cast(float, __builtin_amdgcn_readlane(coef, 40)), __builtin_bit_cast(float, __builtin_amdgcn_readlane(coef, 24)), __builtin_bit_cast(float, __builtin_amdgcn_readlane(coef, 56)) };
#pragma unroll
    for (int j = 0; j < 8; ++j) { float f[16]; dec4(B.v[j], f);
#pragma unroll
        for (int i = 0; i < 16; ++i) acc[i] += c[j] * f[i]; }
}
__device__ __forceinline__ int tok_fetch(unsigned* qhead, int lane) {
    unsigned v = 0u;
    if (lane == 0) v = __hip_atomic_fetch_add(qhead, 1u, __ATOMIC_RELAXED, __HIP_MEMORY_SCOPE_AGENT);
    return (int)__builtin_amdgcn_readfirstlane(v);
}
__device__ __forceinline__ void p_peer_apply4(const bf16* HN2, const int* IDX, const float* GATE, const PeerTabs Tb, const float* SS2, const float* gffn, const float* gfin, float* HOUT, unsigned* qhead, int lane) {
    PeerBuf8 A, Bq;
    const int xq = (int)(blockIdx.x & 7u); qhead += 64 * xq;
    auto TOKID = [xq](int q_) { return q_ < (T / 8) ? xq + 8 * q_ : T; };
    int t = TOKID(tok_fetch(qhead, lane)), t1 = TOKID(tok_fetch(qhead, lane));
    int i0 = 0, i1 = 0;
    float su0 = 0.f, su1 = 0.f, sv0 = 0.f, sv1 = 0.f;
    if (t < T) { i0 = IDX[(size_t)t * 128 + lane]; i1 = IDX[(size_t)t * 128 + 64 + lane]; su0 = Tb.SU[i0]; su1 = Tb.SU[i1]; sv0 = Tb.SV[i0]; sv1 = Tb.SV[i1]; peer_load8(A, Tb, i0, i1, 0, lane); }
    while (t < T) {
        const int t2 = TOKID(tok_fetch(qhead, lane));
        v2u hw[4];
        const float xs = 1.0f / sqrtf(SS2[t] * (1.0f / DM) + EPS);
#pragma unroll
        for (int j = 0; j < 4; ++j) hw[j] = *(const v2u*)(HN2 + (size_t)t * DM + 256 * j + 4 * lane);
        const unsigned xw[8] = {hw[0].x, hw[0].y, hw[1].x, hw[1].y, hw[2].x, hw[2].y, hw[3].x, hw[3].y};
        const float gs0 = GATE[(size_t)t * 128 + lane] * sv0, gs1 = GATE[(size_t)t * 128 + 64 + lane] * sv1;
        const int tn = t1 < T ? t1 : t;
        const int n0 = IDX[(size_t)tn * 128 + lane], n1 = IDX[(size_t)tn * 128 + 64 + lane];
        float acc[16];
#pragma unroll
        for (int i = 0; i < 16; ++i) acc[i] = 0.f;
        float nu0 = 0.f, nu1 = 0.f, nv0 = 0.f, nv1 = 0.f;
        for (int hh = 0; hh < 16; hh += 2) {
            peer_load8(Bq, Tb, i0, i1, hh + 1, lane);
            peer_compute8(A, xw, xs, gs0, gs1, su0, su1, hh, lane, acc);
            if (hh == 2) { nu0 = Tb.SU[n0]; nu1 = Tb.SU[n1]; nv0 = Tb.SV[n0]; nv1 = Tb.SV[n1]; }
            if (hh + 2 < 16) peer_load8(A, Tb, i0, i1, hh + 2, lane); else peer_load8(A, Tb, n0, n1, 0, lane);
            peer_compute8(Bq, xw, xs, gs0, gs1, su0, su1, hh + 1, lane, acc);
        }
        i0 = n0; i1 = n1; su0 = nu0; su1 = nu1; sv0 = nv0; sv1 = nv1;
        float* hp = HOUT + (size_t)t * DM + 4 * lane;
        f32x4 y[4]; float ss = 0.f;
#pragma unroll
        for (int j = 0; j < 4; ++j) { const f32x4 gf = *(const f32x4*)(gffn + 256 * j + 4 * lane);
            const f32x4 hv = (f32x4){bfl(hw[j].x) * __builtin_amdgcn_rcpf(gf.x), bfh(hw[j].x) * __builtin_amdgcn_rcpf(gf.y), bfl(hw[j].y) * __builtin_amdgcn_rcpf(gf.z), bfh(hw[j].y) * __builtin_amdgcn_rcpf(gf.w)};
            y[j] = hv + (f32x4){acc[4 * j], acc[4 * j + 1], acc[4 * j + 2], acc[4 * j + 3]}; ss += (y[j].x * y[j].x + y[j].y * y[j].y) + (y[j].z * y[j].z + y[j].w * y[j].w); }
        const float rstd = 1.0f / sqrtf(wave_sum(ss) * (1.0f / DM) + EPS);
        const float* gp = gfin + 4 * lane;
#pragma unroll
        for (int j = 0; j < 4; ++j) *(f32x4*)(hp + 256 * j) = y[j] * rstd * *(const f32x4*)(gp + 256 * j);
        t = t1; t1 = t2;
    }
}

typedef short s16x4 __attribute__((ext_vector_type(4)));
typedef short v4i16_t __attribute__((ext_vector_type(4)));
__device__ __forceinline__ s16x4 lds_tr16(LAS unsigned char* p) { return __builtin_bit_cast(s16x4, __builtin_amdgcn_ds_read_tr16_b64_v4i16((LAS v4i16_t*)p)); }
__device__ __forceinline__ bf16x8 cat8(s16x4 a, s16x4 b) { return (bf16x8){a[0], a[1], a[2], a[3], b[0], b[1], b[2], b[3]}; }
constexpr int RP_QK = 144, RP_V = 288;
struct QkRegs { v4u a, b; };
struct CsRegs { f32x4 c0, c1, s0, s1; };
struct VRegs { v4u a, b, c, d; };
__device__ __forceinline__ void qk_issue(QkRegs& R, const bf16* src, int tid) { const int j = tid >> 2, part = tid & 3; const bf16* rp = src + (size_t)j * 512; R.a = *(const v4u*)(rp + 8 * part); R.b = *(const v4u*)(rp + 32 + 8 * part); }
__device__ __forceinline__ void cs_issue(CsRegs& R, int pos0, const float* cosR, const float* sinR, int tid) { const int j = tid >> 2, part = tid & 3;
    const float* cp = cosR + (size_t)(pos0 + j) * 32 + 8 * part; const float* sp = sinR + (size_t)(pos0 + j) * 32 + 8 * part;
    R.c0 = *(const f32x4*)cp; R.c1 = *(const f32x4*)(cp + 4); R.s0 = *(const f32x4*)sp; R.s1 = *(const f32x4*)(sp + 4); }
__device__ __forceinline__ void v_issue(VRegs& R, const bf16* src, int tid) { const int j = tid >> 2, part = tid & 3; const v4u* rp = (const v4u*)(src + (size_t)j * 1024 + 32 * part); R.a = rp[0]; R.b = rp[1]; R.c = rp[2]; R.d = rp[3]; }
__device__ __forceinline__ void qk_finish(LAS unsigned char* dst, const QkRegs& R, const CsRegs& C, float base, float lg2, int wmode, int tid) {
    const int j = tid >> 2, part = tid & 3;
    const v4u a = R.a, b = R.b;
    const float sc = wmode ? base * __builtin_amdgcn_exp2f(lg2 * (float)(127 - j)) : base;
    const float x1[8] = {bfl(a.x), bfh(a.x), bfl(a.y), bfh(a.y), bfl(a.z), bfh(a.z), bfl(a.w), bfh(a.w)};
    const float x2[8] = {bfl(b.x), bfh(b.x), bfl(b.y), bfh(b.y), bfl(b.z), bfh(b.z), bfl(b.w), bfh(b.w)};
    const float cc[8] = {C.c0.x, C.c0.y, C.c0.z, C.c0.w, C.c1.x, C.c1.y, C.c1.z, C.c1.w}, ss[8] = {C.s0.x, C.s0.y, C.s0.z, C.s0.w, C.s1.x, C.s1.y, C.s1.z, C.s1.w};
    float o1[8], o2[8];
#pragma unroll
    for (int e = 0; e < 8; ++e) { o1[e] = (x1[e] * cc[e] - x2[e] * ss[e]) * sc; o2[e] = (x2[e] * cc[e] + x1[e] * ss[e]) * sc; }
    v4u w1, w2; w1.x = pk2(o1[0], o1[1]); w1.y = pk2(o1[2], o1[3]); w1.z = pk2(o1[4], o1[5]); w1.w = pk2(o1[6], o1[7]);
    w2.x = pk2(o2[0], o2[1]); w2.y = pk2(o2[2], o2[3]); w2.z = pk2(o2[4], o2[5]); w2.w = pk2(o2[6], o2[7]);
    *(LAS v4u*)(dst + j * RP_QK + 16 * part) = w1; *(LAS v4u*)(dst + j * RP_QK + 64 + 16 * part) = w2;
}
__device__ __forceinline__ void v_finish(LAS unsigned char* dst, const VRegs& R, int tid) { const int j = tid >> 2, part = tid & 3; LAS v4u* dp = (LAS v4u*)(dst + j * RP_V + 64 * part); dp[0] = R.a; dp[1] = R.b; dp[2] = R.c; dp[3] = R.d; }
__device__ __forceinline__ void p_ret_kv(LAS unsigned char* lds, const bf16* KR, const bf16* VR, const float* tab, bf16* KVT, int bid, int G, int wave, int lane) {
    LAS unsigned char* Ks = lds; LAS unsigned char* Vs = lds + 128 * RP_QK;
    const float* cosR = tab + 2048 * 16, *sinR = tab + 2048 * 16 + 2048 * 32;
    const int tid = threadIdx.x, c = lane & 15, g = lane >> 4, q = c >> 2, p = c & 3;
    QkRegs kq; CsRegs cs; VRegs vv;
    if (bid < 1024) { const int b = bid & 7, n = (bid >> 3) & 15, h = bid >> 7; const size_t row0 = (size_t)b * SEQ + n * 128;
        qk_issue(kq, KR + row0 * 512 + h * 64, tid); cs_issue(cs, n * 128, cosR, sinR, tid); v_issue(vv, VR + row0 * 1024 + h * 128, tid); }
    for (int u = bid; u < 1024; u += G) {
        const int b = u & 7, n = (u >> 3) & 15, h = u >> 7;
        const float lg2 = log2f(1.0f - exp2f(-5.0f - (float)h));
        __syncthreads();
        qk_finish(Ks, kq, cs, 0.125f, lg2, 1, tid);
        v_finish(Vs, vv, tid);
        __syncthreads();
        { const int u2 = u + G; if (u2 < 1024) { const int b2 = u2 & 7, n2 = (u2 >> 3) & 15, h2 = u2 >> 7; const size_t r2 = (size_t)b2 * SEQ + n2 * 128;
            qk_issue(kq, KR + r2 * 512 + h2 * 64, tid); cs_issue(cs, n2 * 128, cosR, sinR, tid); v_issue(vv, VR + r2 * 1024 + h2 * 128, tid); } }
        const int e0 = 16 * wave;
        f32x4 acc[4];
#pragma unroll
        for (int dt = 0; dt < 4; ++dt) acc[dt] = (f32x4){0.f, 0.f, 0.f, 0.f};
#pragma unroll
        for (int ks = 0; ks < 4; ++ks) {
            const int key0 = 32 * ks + 4 * g + q;
            const bf16x8 a = cat8(lds_tr16(Vs + key0 * RP_V + (e0 + 4 * p) * 2), lds_tr16(Vs + (key0 + 16) * RP_V + (e0 + 4 * p) * 2));
#pragma unroll
            for (int dt = 0; dt < 4; ++dt) {
                const bf16x8 bb = cat8(lds_tr16(Ks + key0 * RP_QK + (16 * dt + 4 * p) * 2), lds_tr16(Ks + (key0 + 16) * RP_QK + (16 * dt + 4 * p) * 2));
                acc[dt] = __builtin_amdgcn_mfma_f32_16x16x32_bf16(a, bb, acc[dt], 0, 0, 0);
            }
        }
        bf16* op = KVT + (size_t)((b * 8 + h) * 16 + n) * 8192;
#pragma unroll
        for (int dt = 0; dt < 4; ++dt)
#pragma unroll
            for (int r = 0; r < 4; ++r) op[(e0 + 4 * g + r) * 64 + 16 * dt + c] = (bf16)f2bf(acc[dt][r]);
    }
    __syncthreads();
}
__device__ __forceinline__ void p_ret_out(LAS unsigned char* lds, const bf16* QR, const bf16* KR, const bf16* VRIN, bf16* RETOUT, const bf16* GR, const float* tab, const bf16* KVT, int bid, int G, int wave, int lane) {
    LAS unsigned char* Qs = lds; LAS unsigned char* Ks = lds + 128 * RP_QK; LAS unsigned char* STs = lds + 2 * 128 * RP_QK; LAS unsigned char* Vs = lds + 3 * 128 * RP_QK;
    const float* cosR = tab + 2048 * 16, *sinR = tab + 2048 * 16 + 2048 * 32;
    const int tid = threadIdx.x, c = lane & 15, g = lane >> 4, q = c >> 2, p = c & 3;
    for (int item = bid; item < 256; item += G) {
        const int b = item & 7, h = (item >> 5) & 7, n0 = ((item >> 3) & 3) * 4;
        const float lg2 = log2f(1.0f - exp2f(-5.0f - (float)h));
        const float gC = __builtin_amdgcn_exp2f(lg2 * 128.0f);
        const bf16* kvb = KVT + (size_t)((b * 8 + h) * 16) * 8192;
        f32x4 S[4];
#pragma unroll
        for (int k = 0; k < 4; ++k) S[k] = (f32x4){0.f, 0.f, 0.f, 0.f};
        QkRegs qq, kq; CsRegs cs; VRegs vv;
        { const size_t r1 = (size_t)b * SEQ + n0 * 128; qk_issue(qq, QR + r1 * 512 + h * 64, tid); qk_issue(kq, KR + r1 * 512 + h * 64, tid); cs_issue(cs, n0 * 128, cosR, sinR, tid); v_issue(vv, VRIN + r1 * 1024 + h * 128, tid); }
        for (int m = 0; m < n0; m += 4) {
            v2u w[4][4];
#pragma unroll
            for (int mm = 0; mm < 4; ++mm)
#pragma unroll
                for (int k = 0; k < 4; ++k) w[mm][k] = *(const v2u*)(kvb + (size_t)(m + mm) * 8192 + tid * 4 + 2048 * k);
#pragma unroll
            for (int mm = 0; mm < 4; ++mm)
#pragma unroll
                for (int k = 0; k < 4; ++k) S[k] = S[k] * gC + (f32x4){bfl(w[mm][k].x), bfh(w[mm][k].x), bfl(w[mm][k].y), bfh(w[mm][k].y)};
        }
        for (int n = n0; n < n0 + 4; ++n) {
            const size_t row0 = (size_t)b * SEQ + n * 128;
            __syncthreads();
#pragma unroll
            for (int k = 0; k < 4; ++k) { v2u w; w.x = pk2(S[k].x, S[k].y); w.y = pk2(S[k].z, S[k].w); *(LAS v2u*)(STs + ((tid >> 4) + 32 * k) * RP_QK + (tid & 15) * 8) = w; }
            qk_finish(Qs, qq, cs, 1.0f, lg2, 0, tid);
            qk_finish(Ks, kq, cs, 0.125f, lg2, 0, tid);
            v_finish(Vs, vv, tid);
            __syncthreads();
            if (n + 1 < n0 + 4) { const size_t r2 = row0 + 128;
                qk_issue(qq, QR + r2 * 512 + h * 64, tid); qk_issue(kq, KR + r2 * 512 + h * 64, tid); cs_issue(cs, (n + 1) * 128, cosR, sinR, tid); v_issue(vv, VRIN + r2 * 1024 + h * 128, tid); }
            v4u GF[4];
            { const size_t rog = (row0 + 16 * wave + (lane >> 4)) * 1024 + h * 128 + 8 * (lane & 15);
#pragma unroll
              for (int j = 0; j < 4; ++j) GF[j] = *(const v4u*)(GR + rog + (size_t)(4 * j) * 1024); }
            const int i0 = 16 * wave;
            bf16x8 qf[2];
#pragma unroll
            for (int kd = 0; kd < 2; ++kd) qf[kd] = *(const LAS bf16x8*)(Qs + (i0 + c) * RP_QK + (32 * kd + 8 * g) * 2);
            f32x4 acc[8];
#pragma unroll
            for (int et = 0; et < 8; ++et) acc[et] = (f32x4){0.f, 0.f, 0.f, 0.f};
#pragma unroll
            for (int et = 0; et < 8; ++et)
#pragma unroll
                for (int kd = 0; kd < 2; ++kd) {
                    const bf16x8 a = *(const LAS bf16x8*)(STs + (16 * et + c) * RP_QK + (32 * kd + 8 * g) * 2);
                    acc[et] = __builtin_amdgcn_mfma_f32_16x16x32_bf16(a, qf[kd], acc[et], 0, 0, 0);
                }
            { const float wq = __builtin_amdgcn_exp2f(lg2 * (float)(i0 + c + 1));
#pragma unroll
              for (int et = 0; et < 8; ++et) acc[et] = acc[et] * wq; }
            const int nks = (wave >> 1) + 1;
            for (int ks = 0; ks < nks; ++ks) {
                f32x4 p0 = (f32x4){0.f, 0.f, 0.f, 0.f}, p1 = (f32x4){0.f, 0.f, 0.f, 0.f};
#pragma unroll
                for (int kd = 0; kd < 2; ++kd) {
                    const bf16x8 a0 = *(const LAS bf16x8*)(Ks + (32 * ks + c) * RP_QK + (32 * kd + 8 * g) * 2);
                    const bf16x8 a1 = *(const LAS bf16x8*)(Ks + (32 * ks + 16 + c) * RP_QK + (32 * kd + 8 * g) * 2);
                    p0 = __builtin_amdgcn_mfma_f32_16x16x32_bf16(a0, qf[kd], p0, 0, 0, 0);
                    p1 = __builtin_amdgcn_mfma_f32_16x16x32_bf16(a1, qf[kd], p1, 0, 0, 0);
                }
                const int i = i0 + c;
                float d0[4], d1[4];
#pragma unroll
                for (int r = 0; r < 4; ++r) {
                    const int dl0 = i - (32 * ks + 4 * g + r), dl1 = dl0 - 16;
                    d0[r] = dl0 >= 0 ? p0[r] * __builtin_amdgcn_exp2f(lg2 * (float)dl0) : 0.f;
                    d1[r] = dl1 >= 0 ? p1[r] * __builtin_amdgcn_exp2f(lg2 * (float)dl1) : 0.f;
                }
                v4u pw; pw.x = pk2(d0[0], d0[1]); pw.y = pk2(d0[2], d0[3]); pw.z = pk2(d1[0], d1[1]); pw.w = pk2(d1[2], d1[3]);
                const bf16x8 pb = __builtin_bit_cast(bf16x8, pw);
                const int key0 = 32 * ks + 4 * g + q;
#pragma unroll
                for (int et = 0; et < 8; ++et) {
                    const bf16x8 a = cat8(lds_tr16(Vs + key0 * RP_V + (16 * et + 4 * p) * 2), lds_tr16(Vs + (key0 + 16) * RP_V + (16 * et + 4 * p) * 2));
                    acc[et] = __builtin_amdgcn_mfma_f32_16x16x32_bf16(a, pb, acc[et], 0, 0, 0);
                }
            }
            float ssq = 0.f;
#pragma unroll
            for (int et = 0; et < 8; ++et) ssq += (acc[et].x * acc[et].x + acc[et].y * acc[et].y) + (acc[et].z * acc[et].z + acc[et].w * acc[et].w);
            ssq += __shfl_xor(ssq, 16); ssq += __shfl_xor(ssq, 32);
            const float rs = 1.0f / sqrtf(ssq * (1.0f / 128.0f) + EPS);
            { LAS unsigned char* ost = lds + 3 * 128 * RP_QK + 128 * RP_V + wave * (16 * 272);
#pragma unroll
              for (int et = 0; et < 8; ++et) { v2u o; o.x = pk2(acc[et].x * rs, acc[et].y * rs); o.y = pk2(acc[et].z * rs, acc[et].w * rs); *(LAS v2u*)(ost + c * 272 + (16 * et + 4 * g) * 2) = o; }
              asm volatile("s_waitcnt lgkmcnt(0)" ::: "memory");
              const size_t ro = (row0 + i0 + (lane >> 4)) * 1024 + h * 128 + 8 * (lane & 15);
#pragma unroll
              for (int j = 0; j < 4; ++j) {
                  const v4u ov = *(const LAS v4u*)(ost + (4 * j + (lane >> 4)) * 272 + 16 * (lane & 15));
                  const unsigned ow[4] = {ov.x, ov.y, ov.z, ov.w}, gw4[4] = {GF[j].x, GF[j].y, GF[j].z, GF[j].w};
                  v4u r4; unsigned rw[4];
#pragma unroll
                  for (int i = 0; i < 4; ++i) { const float g0 = bfl(gw4[i]), g1 = bfh(gw4[i]); rw[i] = pk2(g0 / (1.f + __expf(-g0)) * bfl(ow[i]), g1 / (1.f + __expf(-g1)) * bfh(ow[i])); }
                  r4.x = rw[0]; r4.y = rw[1]; r4.z = rw[2]; r4.w = rw[3];
                  *(v4u*)(RETOUT + ro + (size_t)(4 * j) * 1024) = r4;
              }
              asm volatile("s_waitcnt lgkmcnt(0)" ::: "memory"); }
            if (n < n0 + 3) {
#pragma unroll
                for (int k = 0; k < 4; ++k) { const v2u w = *(const v2u*)(kvb + (size_t)n * 8192 + tid * 4 + 2048 * k); S[k] = S[k] * gC + (f32x4){bfl(w.x), bfh(w.x), bfl(w.y), bfh(w.y)}; }
            }
        }
    }
    __syncthreads();
}
constexpr int RP_A = 144;
__device__ __forceinline__ void p_attn(LAS unsigned char* lds, const bf16* QA, const bf16* KVA, const float* tab, const float* sinks, bf16* ATT, int bid, int G, int wave, int lane) {
    LAS unsigned char* Ks = lds; LAS unsigned char* Vs = lds + 272 * RP_A;
    const float* cosA = tab, *sinA = tab + 2048 * 8;
    const int tid = threadIdx.x, c = lane & 15, g = lane >> 4, q = c >> 2, p = c & 3;
    constexpr float QS = 0.125f * 1.4426950408889634f;
    for (int u = bid; u < 256; u += G) {
        const int b = u & 7, kvh = (u >> 3) & 1, nb = u >> 4;
        __syncthreads();
        { const int row = tid >> 1, half = tid & 1, pos = nb * 128 - 128 + row;
          v4u k0 = (v4u){0u, 0u, 0u, 0u}, k1 = k0, k2 = k0, k3 = k0, v0 = k0, v1 = k0, v2 = k0, v3 = k0;
          if (pos >= 0) {
              const v4u* kp = (const v4u*)(KVA + (size_t)(b * SEQ + pos) * 256 + kvh * 64 + 32 * half); const v4u* vp = kp + 16;
              k0 = kp[0]; k1 = kp[1]; k2 = kp[2]; k3 = kp[3]; v0 = vp[0]; v1 = vp[1]; v2 = vp[2]; v3 = vp[3];
              if (half == 0) {
                  const f32x4 c0 = *(const f32x4*)(cosA + pos * 8), c1 = *(const f32x4*)(cosA + pos * 8 + 4), s0 = *(const f32x4*)(sinA + pos * 8), s1 = *(const f32x4*)(sinA + pos * 8 + 4);
                  const float x1[8] = {bfl(k0.x), bfh(k0.x), bfl(k0.y), bfh(k0.y), bfl(k0.z), bfh(k0.z), bfl(k0.w), bfh(k0.w)};
                  const float x2[8] = {bfl(k1.x), bfh(k1.x), bfl(k1.y), bfh(k1.y), bfl(k1.z), bfh(k1.z), bfl(k1.w), bfh(k1.w)};
                  const float cc[8] = {c0.x, c0.y, c0.z, c0.w, c1.x, c1.y, c1.z, c1.w}, ss[8] = {s0.x, s0.y, s0.z, s0.w, s1.x, s1.y, s1.z, s1.w};
                  float o1[8], o2[8];
#pragma unroll
                  for (int e = 0; e < 8; ++e) { o1[e] = x1[e] * cc[e] - x2[e] * ss[e]; o2[e] = x2[e] * cc[e] + x1[e] * ss[e]; }
                  k0.x = pk2(o1[0], o1[1]); k0.y = pk2(o1[2], o1[3]); k0.z = pk2(o1[4], o1[5]); k0.w = pk2(o1[6], o1[7]);
                  k1.x = pk2(o2[0], o2[1]); k1.y = pk2(o2[2], o2[3]); k1.z = pk2(o2[4], o2[5]); k1.w = pk2(o2[6], o2[7]);
              }
          }
          LAS v4u* kd = (LAS v4u*)(Ks + row * RP_A + 64 * half); LAS v4u* vd = (LAS v4u*)(Vs + row * RP_A + 64 * half);
          kd[0] = k0; kd[1] = k1; kd[2] = k2; kd[3] = k3; vd[0] = v0; vd[1] = v1; vd[2] = v2; vd[3] = v3;
          if (tid < 128) { const int pr = 256 + (tid >> 3), ch = tid & 7; *(LAS v4u*)(Ks + pr * RP_A + 16 * ch) = (v4u){0u, 0u, 0u, 0u}; *(LAS v4u*)(Vs + pr * RP_A + 16 * ch) = (v4u){0u, 0u, 0u, 0u}; }
        }
        __syncthreads();
        const int hq = kvh * 4 + (wave >> 1), qh = wave & 1;
        const float sink2 = sinks[hq] * 1.4426950408889634f;
        for (int it = 0; it < 4; ++it) {
            const int il0 = 64 * qh + 16 * it, base = il0;
            const int tq = nb * 128 + il0 + c;
            const size_t qrow = (size_t)b * SEQ + tq;
            v4u qa = *(const v4u*)(QA + qrow * 512 + hq * 64 + 8 * g), qb = *(const v4u*)(QA + qrow * 512 + hq * 64 + 32 + 8 * g);
            { v4u pa; pa.x = __shfl_xor(qa.x, 16); pa.y = __shfl_xor(qa.y, 16); pa.z = __shfl_xor(qa.z, 16); pa.w = __shfl_xor(qa.w, 16);
              const f32x4 c0 = *(const f32x4*)(cosA + tq * 8), c1 = *(const f32x4*)(cosA + tq * 8 + 4), s0 = *(const f32x4*)(sinA + tq * 8), s1 = *(const f32x4*)(sinA + tq * 8 + 4);
              const float mine[8] = {bfl(qa.x), bfh(qa.x), bfl(qa.y), bfh(qa.y), bfl(qa.z), bfh(qa.z), bfl(qa.w), bfh(qa.w)};
              const float oth[8] = {bfl(pa.x), bfh(pa.x), bfl(pa.y), bfh(pa.y), bfl(pa.z), bfh(pa.z), bfl(pa.w), bfh(pa.w)};
              const float cc[8] = {c0.x, c0.y, c0.z, c0.w, c1.x, c1.y, c1.z, c1.w}, ss[8] = {s0.x, s0.y, s0.z, s0.w, s1.x, s1.y, s1.z, s1.w};
              float o[8];
#pragma unroll
              for (int e = 0; e < 8; ++e) { const float rot = g == 0 ? mine[e] * cc[e] - oth[e] * ss[e] : mine[e] * cc[e] + oth[e] * ss[e]; o[e] = (g < 2 ? rot : mine[e]) * QS; }
              qa.x = pk2(o[0], o[1]); qa.y = pk2(o[2], o[3]); qa.z = pk2(o[4], o[5]); qa.w = pk2(o[6], o[7]);
              qb.x = pk2(bfl(qb.x) * QS, bfh(qb.x) * QS); qb.y = pk2(bfl(qb.y) * QS, bfh(qb.y) * QS); qb.z = pk2(bfl(qb.z) * QS, bfh(qb.z) * QS); qb.w = pk2(bfl(qb.w) * QS, bfh(qb.w) * QS); }
            const bf16x8 qf0 = __builtin_bit_cast(bf16x8, qa), qf1 = __builtin_bit_cast(bf16x8, qb);
            f32x4 s[10];
#pragma unroll
            for (int jt = 0; jt < 10; ++jt) {
                const bf16x8 a0 = *(const LAS bf16x8*)(Ks + (base + 16 * jt + c) * RP_A + (8 * g) * 2);
                const bf16x8 a1 = *(const LAS bf16x8*)(Ks + (base + 16 * jt + c) * RP_A + (32 + 8 * g) * 2);
                s[jt] = __builtin_amdgcn_mfma_f32_16x16x32_bf16(a0, qf0, (f32x4){0.f, 0.f, 0.f, 0.f}, 0, 0, 0);
                s[jt] = __builtin_amdgcn_mfma_f32_16x16x32_bf16(a1, qf1, s[jt], 0, 0, 0);
            }
            const int qi = 128 + il0 + c;
            float m = sink2;
#pragma unroll
            for (int jt = 0; jt < 10; ++jt)
#pragma unroll
                for (int r = 0; r < 4; ++r) {
                    const int kj = base + 16 * jt + 4 * g + r, df = qi - kj;
                    const bool ok = (df >= 0) && (df < 128) && (nb > 0 || kj >= 128);
                    s[jt][r] = ok ? s[jt][r] : -INFINITY;
                    m = fmaxf(m, s[jt][r]);
                }
            m = fmaxf(m, __shfl_xor(m, 16)); m = fmaxf(m, __shfl_xor(m, 32));
            float l = 0.f;
#pragma unroll
            for (int jt = 0; jt < 10; ++jt)
#pragma unroll
                for (int r = 0; r < 4; ++r) { s[jt][r] = __builtin_amdgcn_exp2f(s[jt][r] - m); l += s[jt][r]; }
            l += __shfl_xor(l, 16); l += __shfl_xor(l, 32);
            l += __builtin_amdgcn_exp2f(sink2 - m);
            f32x4 acc[4];
#pragma unroll
            for (int dt = 0; dt < 4; ++dt) acc[dt] = (f32x4){0.f, 0.f, 0.f, 0.f};
#pragma unroll
            for (int ks = 0; ks < 5; ++ks) {
                v4u pw; pw.x = pk2(s[2 * ks][0], s[2 * ks][1]); pw.y = pk2(s[2 * ks][2], s[2 * ks][3]); pw.z = pk2(s[2 * ks + 1][0], s[2 * ks + 1][1]); pw.w = pk2(s[2 * ks + 1][2], s[2 * ks + 1][3]);
                const bf16x8 pb = __builtin_bit_cast(bf16x8, pw);
                const int key0 = base + 32 * ks + 4 * g + q;
#pragma unroll
                for (int dt = 0; dt < 4; ++dt) {
                    const bf16x8 a = cat8(lds_tr16(Vs + key0 * RP_A + (16 * dt + 4 * p) * 2), lds_tr16(Vs + (key0 + 16) * RP_A + (16 * dt + 4 * p) * 2));
                    acc[dt] = __builtin_amdgcn_mfma_f32_16x16x32_bf16(a, pb, acc[dt], 0, 0, 0);
                }
            }
            const float rl = 1.0f / l;
            bf16* op = ATT + qrow * 1024 + hq * 64 + 4 * g;
#pragma unroll
            for (int dt = 0; dt < 4; ++dt) { v2u o; o.x = pk2(acc[dt].x * rl, acc[dt].y * rl); o.y = pk2(acc[dt].z * rl, acc[dt].w * rl); *(v2u*)(op + 16 * dt) = o; }
        }
    }
    __syncthreads();
}

constexpr int RP_SK = 272;
constexpr int ROUTE_SCR = 2 * 128 * RP_SK;
#define CE(x, y) do { const int hi_ = max((x), (y)), lo_ = min((x), (y)); (x) = hi_; (y) = lo_; } while (0)
__device__ __forceinline__ int packkey(float f, int idx, unsigned keep) { const int b = __builtin_bit_cast(int, f); const int s = b ^ ((b >> 31) & 0x7fffffff); return (int)(((unsigned)s & keep) | (unsigned)idx); }
__device__ __forceinline__ float keyval(int k, unsigned keep) { const int s = (int)((unsigned)k & keep); return __builtin_bit_cast(float, s ^ ((s >> 31) & 0x7fffffff)); }
__device__ __forceinline__ void sort16(int (&a)[16]) {
    CE(a[0], a[1]); CE(a[3], a[2]); CE(a[4], a[5]); CE(a[7], a[6]); CE(a[8], a[9]); CE(a[11], a[10]);
    CE(a[12], a[13]); CE(a[15], a[14]); CE(a[0], a[2]); CE(a[1], a[3]); CE(a[6], a[4]); CE(a[7], a[5]);
    CE(a[8], a[10]); CE(a[9], a[11]); CE(a[14], a[12]); CE(a[15], a[13]); CE(a[0], a[1]); CE(a[2], a[3]);
    CE(a[5], a[4]); CE(a[7], a[6]); CE(a[8], a[9]); CE(a[10], a[11]); CE(a[13], a[12]); CE(a[15], a[14]);
    CE(a[0], a[4]); CE(a[1], a[5]); CE(a[2], a[6]); CE(a[3], a[7]); CE(a[12], a[8]); CE(a[13], a[9]);
    CE(a[14], a[10]); CE(a[15], a[11]); CE(a[0], a[2]); CE(a[1], a[3]); CE(a[4], a[6]); CE(a[5], a[7]);
    CE(a[10], a[8]); CE(a[11], a[9]); CE(a[14], a[12]); CE(a[15], a[13]); CE(a[0], a[1]); CE(a[2], a[3]);
    CE(a[4], a[5]); CE(a[6], a[7]); CE(a[9], a[8]); CE(a[11], a[10]); CE(a[13], a[12]); CE(a[15], a[14]);
    CE(a[0], a[8]); CE(a[1], a[9]); CE(a[2], a[10]); CE(a[3], a[11]); CE(a[4], a[12]); CE(a[5], a[13]);
    CE(a[6], a[14]); CE(a[7], a[15]); CE(a[0], a[4]); CE(a[1], a[5]); CE(a[2], a[6]); CE(a[3], a[7]);
    CE(a[8], a[12]); CE(a[9], a[13]); CE(a[10], a[14]); CE(a[11], a[15]); CE(a[0], a[2]); CE(a[1], a[3]);
    CE(a[4], a[6]); CE(a[5], a[7]); CE(a[8], a[10]); CE(a[9], a[11]); CE(a[12], a[14]); CE(a[13], a[15]);
    CE(a[0], a[1]); CE(a[2], a[3]); CE(a[4], a[5]); CE(a[6], a[7]); CE(a[8], a[9]); CE(a[10], a[11]);
    CE(a[12], a[13]); CE(a[14], a[15]);
}
__device__ __forceinline__ void merge16(int (&a)[16]) {
    CE(a[0], a[8]); CE(a[1], a[9]); CE(a[2], a[10]); CE(a[3], a[11]); CE(a[4], a[12]); CE(a[5], a[13]);
    CE(a[6], a[14]); CE(a[7], a[15]); CE(a[0], a[4]); CE(a[1], a[5]); CE(a[2], a[6]); CE(a[3], a[7]);
    CE(a[8], a[12]); CE(a[9], a[13]); CE(a[10], a[14]); CE(a[11], a[15]); CE(a[0], a[2]); CE(a[1], a[3]);
    CE(a[4], a[6]); CE(a[5], a[7]); CE(a[8], a[10]); CE(a[9], a[11]); CE(a[12], a[14]); CE(a[13], a[15]);
    CE(a[0], a[1]); CE(a[2], a[3]); CE(a[4], a[5]); CE(a[6], a[7]); CE(a[8], a[9]); CE(a[10], a[11]);
    CE(a[12], a[13]); CE(a[14], a[15]);
}
template <int X> __device__ __forceinline__ void xmerge16(int (&a)[16]) {
    int o[16];
#pragma unroll
    for (int i = 0; i < 16; ++i) o[i] = __shfl_xor(a[15 - i], X);
#pragma unroll
    for (int i = 0; i < 16; ++i) a[i] = max(a[i], o[i]);
    merge16(a);
}
__device__ __forceinline__ void route_half(LAS unsigned char* lds, const bf16* PQ, int p, int t0, int h, int c, int g, int (&ka)[16]) {
    const bf16* qp = PQ + (size_t)(t0 + c) * 2048 + h * 256 + p * 128 + 8 * g;
    bf16x8 qf[4];
#pragma unroll
    for (int ks = 0; ks < 4; ++ks) qf[ks] = *(const bf16x8*)(qp + 32 * ks);
    f32x4 s[8];
#pragma unroll
    for (int kt = 0; kt < 8; ++kt) {
        s[kt] = (f32x4){0.f, 0.f, 0.f, 0.f};
#pragma unroll
        for (int ks = 0; ks < 4; ++ks) {
            const bf16x8 a = *(const LAS bf16x8*)(lds + p * (128 * RP_SK) + (16 * kt + c) * RP_SK + (32 * ks + 8 * g) * 2);
            s[kt] = __builtin_amdgcn_mfma_f32_16x16x32_bf16(a, qf[ks], s[kt], 0, 0, 0);
        }
        if (kt & 1) __builtin_amdgcn_sched_barrier(0);
    }
    int kb[16];
#pragma unroll
    for (int kt = 0; kt < 4; ++kt) {
        ka[4 * kt + 0] = packkey(s[kt].x, (16 * kt + 0) | (g << 2), 0xffffff80); ka[4 * kt + 1] = packkey(s[kt].y, (16 * kt + 1) | (g << 2), 0xffffff80);
        ka[4 * kt + 2] = packkey(s[kt].z, (16 * kt + 2) | (g << 2), 0xffffff80); ka[4 * kt + 3] = packkey(s[kt].w, (16 * kt + 3) | (g << 2), 0xffffff80);
        kb[4 * kt + 0] = packkey(s[kt + 4].x, (16 * (kt + 4) + 0) | (g << 2), 0xffffff80); kb[4 * kt + 1] = packkey(s[kt + 4].y, (16 * (kt + 4) + 1) | (g << 2), 0xffffff80);
        kb[4 * kt + 2] = packkey(s[kt + 4].z, (16 * (kt + 4) + 2) | (g << 2), 0xffffff80); kb[4 * kt + 3] = packkey(s[kt + 4].w, (16 * (kt + 4) + 3) | (g << 2), 0xffffff80);
    }
    sort16(ka); sort16(kb);
#pragma unroll
    for (int i = 0; i < 16; ++i) ka[i] = max(ka[i], kb[15 - i]);
    merge16(ka);
    xmerge16<16>(ka); xmerge16<32>(ka);
}
template <class Sched> __device__ __forceinline__ void p_peer_route2(LAS unsigned char* lds, const bf16* PQ, const bf16* K1b, const bf16* K2b, int* IDX, float* GATE, const Sched& S, int wave, int lane) {
    const int tid = threadIdx.x, c = lane & 15, g = lane >> 4;
    for (int i = tid; i < 4096; i += NTHR) { const int tb = i >> 11, row = (i >> 4) & 127, ch = i & 15;
        *(LAS v4u*)(lds + tb * (128 * RP_SK) + row * RP_SK + ch * 16) = *(const v4u*)((tb ? K2b : K1b) + row * 128 + ch * 8); }
    __syncthreads();
    LAS int* scr = (LAS int*)(lds + ROUTE_SCR + wave * 2048) + c * 32;
    pg8::Unit un;
    for (int ui = 0; S.next(ui, un); ++ui)
    for (int tt = wave; tt < 16; tt += 8) {
        const int h = un.pn, t0 = un.pm * 256 + tt * 16;
        int k1[16], k2[16];
        route_half(lds, PQ, 0, t0, h, c, g, k1);
        route_half(lds, PQ, 1, t0, h, c, g, k2);
        if (g == 0) {
#pragma unroll
            for (int i = 0; i < 16; i += 4) { *(LAS v4u*)(scr + i) = (v4u){(unsigned)k1[i], (unsigned)k1[i + 1], (unsigned)k1[i + 2], (unsigned)k1[i + 3]};
                *(LAS v4u*)(scr + 16 + i) = (v4u){(unsigned)k2[i], (unsigned)k2[i + 1], (unsigned)k2[i + 2], (unsigned)k2[i + 3]}; }
        }
        float f1[16], f2[16];
#pragma unroll
        for (int i = 0; i < 16; ++i) { f1[i] = keyval(k1[i], 0xffffff80); f2[i] = keyval(k2[i], 0xffffff80); }
        int ck[16];
        ck[0] = packkey(g == 0 ? (f1[0] + f2[0]) : g == 1 ? (f1[0] + f2[1]) : g == 2 ? (f1[0] + f2[2]) : (f1[0] + f2[3]), g == 0 ? 0 : g == 1 ? 1 : g == 2 ? 2 : 3, 0xffffff00);
        ck[1] = packkey(g == 0 ? (f1[0] + f2[4]) : g == 1 ? (f1[0] + f2[5]) : g == 2 ? (f1[0] + f2[6]) : (f1[0] + f2[7]), g == 0 ? 4 : g == 1 ? 5 : g == 2 ? 6 : 7, 0xffffff00);
        ck[2] = packkey(g == 0 ? (f1[0] + f2[8]) : g == 1 ? (f1[0] + f2[9]) : g == 2 ? (f1[0] + f2[10]) : (f1[0] + f2[11]), g == 0 ? 8 : g == 1 ? 9 : g == 2 ? 10 : 11, 0xffffff00);
        ck[3] = packkey(g == 0 ? (f1[0] + f2[12]) : g == 1 ? (f1[0] + f2[13]) : g == 2 ? (f1[0] + f2[14]) : (f1[0] + f2[15]), g == 0 ? 12 : g == 1 ? 13 : g == 2 ? 14 : 15, 0xffffff00);
        ck[4] = packkey(g == 0 ? (f1[1] + f2[0]) : g == 1 ? (f1[1] + f2[1]) : g == 2 ? (f1[1] + f2[2]) : (f1[1] + f2[3]), g == 0 ? 16 : g == 1 ? 17 : g == 2 ? 18 : 19, 0xffffff00);
        ck[5] = packkey(g == 0 ? (f1[1] + f2[4]) : g == 1 ? (f1[1] + f2[5]) : g == 2 ? (f1[1] + f2[6]) : (f1[1] + f2[7]), g == 0 ? 20 : g == 1 ? 21 : g == 2 ? 22 : 23, 0xffffff00);
        ck[6] = packkey(g == 0 ? (f1[2] + f2[0]) : g == 1 ? (f1[2] + f2[1]) : g == 2 ? (f1[2] + f2[2]) : (f1[2] + f2[3]), g == 0 ? 32 : g == 1 ? 33 : g == 2 ? 34 : 35, 0xffffff00);
        ck[7] = packkey(g == 0 ? (f1[2] + f2[4]) : g == 1 ? (f1[3] + f2[0]) : g == 2 ? (f1[3] + f2[1]) : (f1[3] + f2[2]), g == 0 ? 36 : g == 1 ? 48 : g == 2 ? 49 : 50, 0xffffff00);
        ck[8] = packkey(g == 0 ? (f1[3] + f2[3]) : g == 1 ? (f1[4] + f2[0]) : g == 2 ? (f1[4] + f2[1]) : (f1[4] + f2[2]), g == 0 ? 51 : g == 1 ? 64 : g == 2 ? 65 : 66, 0xffffff00);
        ck[9] = packkey(g == 0 ? (f1[5] + f2[0]) : g == 1 ? (f1[5] + f2[1]) : g == 2 ? (f1[6] + f2[0]) : (f1[6] + f2[1]), g == 0 ? 80 : g == 1 ? 81 : g == 2 ? 96 : 97, 0xffffff00);
        ck[10] = packkey(g == 0 ? (f1[7] + f2[0]) : g == 1 ? (f1[7] + f2[1]) : g == 2 ? (f1[8] + f2[0]) : (f1[9] + f2[0]), g == 0 ? 112 : g == 1 ? 113 : g == 2 ? 128 : 144, 0xffffff00);
        ck[11] = packkey(g == 0 ? (f1[10] + f2[0]) : g == 1 ? (f1[11] + f2[0]) : g == 2 ? (f1[12] + f2[0]) : (f1[13] + f2[0]), g == 0 ? 160 : g == 1 ? 176 : g == 2 ? 192 : 208, 0xffffff00);
        ck[12] = packkey(g == 0 ? (f1[14] + f2[0]) : g == 1 ? (f1[15] + f2[0]) : g == 2 ? (-3.0e38f) : (-3.0e38f), g == 0 ? 224 : g == 1 ? 240 : g == 2 ? 0 : 0, 0xffffff00);
        ck[13] = (int)0x80000000; ck[14] = (int)0x80000000; ck[15] = (int)0x80000000;
        sort16(ck); xmerge16<16>(ck); xmerge16<32>(ck);
        float den = 0.f; const float tmx = keyval(ck[0], 0xffffff00);
#pragma unroll
        for (int r = 0; r < 16; ++r) den += __expf(keyval(ck[r], 0xffffff00) - tmx);
        const float rden = 1.f / den;
        int mine[4];
#pragma unroll
        for (int j = 0; j < 4; ++j) mine[j] = g == 0 ? ck[j] : g == 1 ? ck[4 + j] : g == 2 ? ck[8 + j] : ck[12 + j];
        asm volatile("s_waitcnt lgkmcnt(0)" ::: "memory");
        v4u eo; f32x4 go;
#pragma unroll
        for (int j = 0; j < 4; ++j) { const int a = (mine[j] >> 4) & 15, b = mine[j] & 15; const int e = ((scr[a] & 127) << 7) | (scr[16 + b] & 127);
            eo[j] = (unsigned)e; go[j] = __expf(keyval(mine[j], 0xffffff00) - tmx) * rden; }
        *(v4u*)(IDX + (size_t)(t0 + c) * 128 + h * 16 + 4 * g) = eo; *(f32x4*)(GATE + (size_t)(t0 + c) * 128 + h * 16 + 4 * g) = go;
        asm volatile("s_waitcnt lgkmcnt(0)" ::: "memory");
    }
    __syncthreads();
}
#undef CE
__global__ void __launch_bounds__(NTHR, 2) mk_fwd(Args args) {
    extern __shared__ __attribute__((aligned(16))) unsigned char lds_raw[];
    LAS unsigned char* lds = (LAS unsigned char*)lds_raw;
    volatile LAS unsigned* MISC = (volatile LAS unsigned*)(lds + MISC_OFF);
    const int tid = threadIdx.x, lane = tid & 63, wave = __builtin_amdgcn_readfirstlane(tid >> 6);
    const int G = gridDim.x, bid = blockIdx.x;
    const int gtid = bid * NTHR + tid, gthreads = G * NTHR, gw = bid * NWAVES + wave, NGW = G * NWAVES;
    unsigned char* ws = args.ws; unsigned char* dob = (unsigned char*)args.out;
    gu32* ctl = (gu32*)(ws + WS_CTL);
    const float* x = args.in[0]; const float* norm_mix = args.in[1]; const float* w_in = args.in[2]; const float* sinks = args.in[3];
    const float* w_att = args.in[4]; const float* w_ret = args.in[5]; const float* w_out = args.in[6]; const float* norm_ffn = args.in[7];
    const float* wq = args.in[8]; const float* k1 = args.in[9]; const float* k2 = args.in[10]; const float* pu = args.in[11]; const float* pv = args.in[12];
    const float* norm_final = args.in[13];
    float* tab = (float*)(ws + WS_TAB);
    for (int u = tid; u < (LDS_BYTES - LDSCTL_OFF) / 4; u += NTHR) ((LAS unsigned*)(lds + LDSCTL_OFF))[u] = 0u;
    __syncthreads();
    const bool multi = (args.ph_hi - args.ph_lo) > 1;
    XcdBarrier bar; bar.bar = (unsigned*)(ctl + CW_BAR); bar.x = 0; bar.st = nullptr;
    if (multi) bar = xcd_barrier_post((unsigned*)(ctl + CW_BAR), MISC + 8);
    const int lo = args.ph_lo, hi = args.ph_hi;
#define IN(k) (lo <= (k) && (k) < hi)
#define SEAM(k) do { if (IN(k) && IN((k) + 1)) xcd_barrier(bar); } while (0)

    constexpr int I_IN = (DM / 64) * (INW / 32), I_A = (512 / 64) * (DM / 32), I_R = (DM / 64) * (DM / 32), I_O = I_R, I_Q = (DM / 64) * (2048 / 32);
    constexpr int NUNITS8 = (T / 256) * (INW / 256), TAB_LATE = 0;
    if (IN(0)) {
        p_tables(tab, gtid, gthreads);
        for (int i = gtid; i < T; i += gthreads) ((float*)(ws + WS_SS2))[i] = 0.f;
        p0_win_i8(w_in, ws + WS_WIN8, (float*)(ws + WS_CSC), (LAS float*)(lds + RING_OFF), bid, G);
        LAS float* scr = (LAS float*)(lds + RING_OFF + wave * 16384);
        for (int m = gw; m < T; m += NGW) rms_row_to_bf16(x + (size_t)m * DM, norm_mix, (bf16*)(dob + DO_HN) + (size_t)m * DM, (unsigned*)(ws + WS_HN8 + (size_t)m * DM), (float*)(ws + WS_RSC) + m, lane);
        for (int i = gtid; i < 2 * 128 * 128 / 4; i += gthreads) {
            const int tb = i >> 12, o = (i & 4095) * 4; const f32x4 v = *(const f32x4*)((tb ? k2 : k1) + o);
            *(unsigned long long*)((bf16*)(ws + (tb ? WS_K2 : WS_K1)) + o) = (unsigned long long)pk2(v.x, v.y) | ((unsigned long long)pk2(v.z, v.w) << 32); }
    }
    SEAM(0);
    if (IN(1)) {
        const int NG8 = G >> 3, NTX = ((G & 7) == 0 && NG8 >= 16) ? 5 : 0, xg = bid >> 3, xq = bid & 7;
        const bool tabwg = NTX > 0 && xg >= NG8 - NTX;
        const int GG = NTX > 0 ? (NG8 - NTX) * 8 : G, cidx = NTX > 0 ? xg * 8 + xq : bid;
        if (!tabwg) {
            { pg8::Gemm8 g{ws + WS_HN8, ws + WS_WIN8, T, INW, DM}; pg8::StaticOrder S; S.init(T, INW, GG, cidx);
              pg8::EpiProjI8 E{ws, dob + DO_GT, (const float*)(ws + WS_RSC), (const float*)(ws + WS_CSC)};
              pg8::gemm_phase_i8<pg8::EpiProjI8, pg8::StaticOrder>(lds + RING_OFF, g, S, E); }
            const int rem = NUNITS8 % GG; const bool share = rem == 0 || cidx >= rem; const int nshare = rem == 0 ? GG : GG - rem, myi = rem == 0 ? cidx : cidx - rem;
            if (share) {
                LAS float* scr = (LAS float*)(lds + RING_OFF + wave * 16384);
                const int gw2 = myi * NWAVES + wave, NGW2 = nshare * NWAVES;
                for (int it = gw2; it < I_A + I_R + I_O + I_Q; it += NGW2) {
                    int r = it;
                    if (r < I_A) { p0_transpose_item(w_att, 512, DM, (bf16*)(ws + WS_WA), scr, r, lane, 1024); continue; } r -= I_A;
                    if (r < I_R) { p0_transpose_item(w_ret, DM, DM, (bf16*)(ws + WS_WR), scr, r, lane); continue; } r -= I_R;
                    if (r < I_O) { p0_transpose_item(w_out, DM, DM, nullptr, scr, r, lane, 0, ws + WS_WO); continue; } r -= I_O;
                    p0_transpose_item(wq, DM, 2048, (bf16*)(ws + WS_WQ), scr, r, lane);
                }
            }
        }
        if (tabwg || NTX == 0) {
            const int ti = NTX > 0 ? (xg - (NG8 - NTX)) * 8 + xq : bid, NGW2 = (NTX > 0 ? NTX * 8 : G) * NWAVES, gw2 = ti * NWAVES + wave;
            for (int m0 = gw2; m0 < 2 * 16384; m0 += 8 * NGW2) {
                const float* xr[8]; unsigned char* o4[8]; float* sc[8];
#pragma unroll
                for (int r = 0; r < 8; ++r) { int m = m0 + r * NGW2; m = m < 2 * 16384 ? m : m0;
                    const int e = m & 16383; const bool isv = m >= 16384;
                    xr[r] = (isv ? pv : pu) + (size_t)e * DM; o4[r] = ws + WS_U4 + (size_t)e * 1024 + (isv ? 512 : 0); sc[r] = (float*)(ws + (isv ? WS_SV : WS_SU)) + e; }
                rows_to_fp4<8>(xr, o4, sc, lane);
            }
        }
    }
    SEAM(1);
    if (IN(2)) {
        p_attn(lds + RING_OFF, (const bf16*)(ws + WS_QA), (const bf16*)(ws + WS_KVA), tab, sinks, (bf16*)(ws + WS_ATT), bid, G, wave, lane);
        p_ret_kv(lds + RING_OFF, (const bf16*)(ws + WS_KR), (const bf16*)(ws + WS_VR), tab, (bf16*)(dob + DO_KVT), bid, G, wave, lane);
    }
    SEAM(2);
    if (IN(3)) {
        p_ret_out(lds + RING_OFF, (const bf16*)(ws + WS_QR), (const bf16*)(ws + WS_KR), (const bf16*)(ws + WS_VR), (bf16*)(ws + WS_RET), (const bf16*)(ws + WS_GR), tab, (const bf16*)(dob + DO_KVT), bid, G, wave, lane);
    }
    SEAM(3);
    if (IN(4)) {
        pg8::Gemm2 g{(const pg8::bf16_t*)(ws + WS_ATT), (const pg8::bf16_t*)(ws + WS_WA), 512, (const pg8::bf16_t*)(ws + WS_RET), (const pg8::bf16_t*)(ws + WS_WR), DM, DM, T, DM};
        pg8::StaticOrder S; S.init(T, DM, G, bid);
        pg8::EpiMerge2 E{ws + WS_GA, dob + DO_GT, ws + WS_MERGED};
        pg8::gemm_phase2<pg8::EpiMerge2>(lds + RING_OFF, g, S, E);
    }
    SEAM(5);
    if (IN(6)) {
        pg8::Gemm8 g{ws + WS_MERGED, ws + WS_WO, T, DM, DM}; pg8::StaticOrder S; S.init(T, DM, G, bid);
        pg8::EpiResid2F8 E{x, args.out, (pg8::bf16_t*)(ws + WS_HN2), norm_ffn, (float*)(ws + WS_SS2)};
        pg8::gemm_phase_f8<pg8::EpiResid2F8, pg8::StaticOrder>(lds + RING_OFF, g, S, E);
    }
    SEAM(6);
    if (IN(7)) {
        pg8::Gemm g{(const pg8::bf16_t*)(ws + WS_HN2), (const pg8::bf16_t*)(ws + WS_WQ), T, 2048, DM}; pg8::StaticOrder S; S.init(T, 2048, G, bid);
        pg8::EpiRowScale E{(pg8::bf16_t*)(ws + WS_PQ), 2048, (const float*)(ws + WS_SS2)};
        pg8::gemm_phase<pg8::EpiRowScale, pg8::StaticOrder, true, true>(lds + RING_OFF, g, S, E);
        asm volatile("s_waitcnt vmcnt(0)" ::: "memory"); __syncthreads();
        p_peer_route2(lds + RING_OFF, (const bf16*)(ws + WS_PQ), (const bf16*)(ws + WS_K1), (const bf16*)(ws + WS_K2), (int*)(ws + WS_IDX), (float*)(ws + WS_GATE), S, wave, lane);
    }
    SEAM(7);
    if (IN(8)) {
        const PeerTabs Tb{ws + WS_U4, ws + WS_V4, (const float*)(ws + WS_SU), (const float*)(ws + WS_SV)};
        p_peer_apply4((const bf16*)(ws + WS_HN2), (const int*)(ws + WS_IDX), (const float*)(ws + WS_GATE), Tb, (const float*)(ws + WS_SS2), norm_ffn, norm_final, args.out, (unsigned*)(ctl + 2048), lane);
    }
#undef IN
#undef SEAM
}

#ifndef MK_PER_PHASE
#define MK_PER_PHASE 0
#endif
constexpr int NPHASE = 9;
extern "C" void kernel_launch(void* const* d_in, const int* in_sizes, int n_in, void* d_out, int out_size, void* d_ws, size_t ws_size, hipStream_t stream) {
    static int grid = 0;
    if (grid == 0) {
        if (n_in != 14 || out_size != T * DM || ws_size < 256 * MiB) { fprintf(stderr, "kernel_launch: unexpected shapes (n_in %d out %d ws %zu)\n", n_in, out_size, ws_size); grid = -1; return; }
        int dev = 0, cus = 0, per_cu = 0;
        if (hipGetDevice(&dev) != hipSuccess || hipDeviceGetAttribute(&cus, hipDeviceAttributeMultiprocessorCount, dev) != hipSuccess) { grid = -1; return; }
        if (hipFuncSetAttribute((const void*)mk_fwd, hipFuncAttributeMaxDynamicSharedMemorySize, LDS_BYTES) != hipSuccess) { fprintf(stderr, "kernel_launch: hipFuncSetAttribute failed\n"); grid = -1; return; }
        if (hipOccupancyMaxActiveBlocksPerMultiprocessor(&per_cu, (const void*)mk_fwd, NTHR, LDS_BYTES) != hipSuccess || per_cu < 1) { fprintf(stderr, "kernel_launch: occupancy query says %d\n", per_cu); per_cu = 1; }
        (void)hipGetLastError();
        grid = cus;
    }
    if (grid < 0) return;
    (void)hipMemsetAsync((char*)d_ws + WS_CTL, 0, CTL_ZERO_BYTES, stream);
    Args a{};
    for (int i = 0; i < 14; ++i) a.in[i] = (const float*)d_in[i];
    a.out = (float*)d_out; a.ws = (unsigned char*)d_ws;
    if (MK_PER_PHASE) {
        for (int p = 0; p < NPHASE; ++p) { a.ph_lo = p; a.ph_hi = p + 1; hipLaunchKernelGGL(mk_fwd, dim3(grid), dim3(NTHR), LDS_BYTES, stream, a); }
    } else {
        a.ph_lo = 0; a.ph_hi = NPHASE;
        hipLaunchKernelGGL(mk_fwd, dim3(grid), dim3(NTHR), LDS_BYTES, stream, a);
    }
}
```

```cpp
#include <hip/hip_runtime.h>
#include <cstdint>
#include <cstdio>
namespace pg8 {
#define PG8_LAS __attribute__((address_space(3)))
typedef unsigned short bf16_t;
typedef short bf16x8 __attribute__((ext_vector_type(8)));
typedef float f32x4 __attribute__((ext_vector_type(4)));
typedef unsigned u32x4 __attribute__((ext_vector_type(4)));
constexpr int BM = 256, BK = 64, HALF = 128, HTB = HALF * BK * 2  , STAGE_BYTES = 8 * HTB, NXCD = 8, WGM = 8;

__host__ __device__ __forceinline__ int lds_byte(int r, int c) { const int st = (r >> 4) * 2 + (c >> 5), rr = r & 15, cc = c & 31, ob = rr * 64 + cc * 2; return st * 1024 + (ob ^ (((ob >> 9) & 1) << 5)); }
__host__ __device__ __forceinline__ void stage_rc(int b, int& R, int& C) { const int st = b / 1024, sb = b % 1024, swz = sb ^ (((sb >> 9) & 1) << 5); R = (st >> 1) * 16 + swz / 64; C = (st & 1) * 32 + (swz % 64) / 2; }
__host__ __device__ __forceinline__ int perm32(int rho) { const int n = rho >> 4, i = rho & 15; return 8 * (i >> 2) + 4 * n + (i & 3); }

struct Unit { int pm, pn; };
struct Gemm { const bf16_t* A; const bf16_t* Bt; int M, N, K; };

struct StaticOrder {
    int nM, nN, nwg, G, c;
    __host__ __device__ void init(int M, int N, int G_, int c_) { nM = M / BM; nN = N / BM; nwg = nM * nN; G = G_; c = c_; }
    __host__ __device__ bool next(int i, Unit& u) const {
        const long L = (long)i * G + c; if (L >= nwg) return false;
        int wgid = (int)L; { const int q = nwg / NXCD, r = nwg % NXCD, xcd = wgid % NXCD, off = wgid / NXCD; wgid = (xcd < r ? xcd * (q + 1) : r * (q + 1) + (xcd - r) * q) + off; }
        const int nig = WGM * nN, gid = wgid / nig, fm = gid * WGM, gsz = (nM - fm) < WGM ? (nM - fm) : WGM;
        u.pm = fm + ((wgid % nig) % gsz); u.pn = (wgid % nig) / gsz; return true;
    }
    __device__ __forceinline__ void a_ready(const Unit&) const {}
    __device__ __forceinline__ void done(const Unit&) const {}
};

__device__ __forceinline__ unsigned cvt_pk_bf16(float lo, float hi) { unsigned r; asm volatile("v_cvt_pk_bf16_f32 %0, %1, %2" : "=v"(r) : "v"(lo), "v"(hi)); return r; }
typedef float f32x2 __attribute__((ext_vector_type(2)));
template <class Epi, class Sched, bool ALIGN_EPI = false, bool SP2 = false>
__device__ __forceinline__ void gemm_phase(PG8_LAS unsigned char* lds, const Gemm g, const Sched& S, const Epi& E) {
    const int tid = threadIdx.x, wid = __builtin_amdgcn_readfirstlane(tid >> 6), lane = tid & 63, wr = wid >> 2, wc = wid & 3, fr = lane & 15, fq = lane >> 4;
    const int K = g.K, nt = K / BK;
    unsigned voffA[2], voffB[2];
#pragma unroll
    for (int i = 0; i < 2; ++i) { int R, C; stage_rc(tid * 16 + i * 8192, R, C); const int Rb = Epi::PERM ? ((R & ~31) + perm32(R & 31)) : R;
        voffA[i] = (unsigned)(R * K + C) * 2u; voffB[i] = (unsigned)(Rb * K + C) * 2u; }
    const size_t kstep = (size_t)(BK * 2);
    const size_t hstep = (size_t)HALF * K * 2;
    const size_t tstep = 2 * hstep;
    const unsigned ldsw = (unsigned)wid * 1024u;
    const int aoff = lds_byte(wr * 64 + fr, fq * 8), boff = lds_byte(wc * 32 + fr, fq * 8);
#define PG8_SA(b, h) (((b) * 2 + (h)) * HTB)
#define PG8_SB(b, h) ((4 + (b) * 2 + (h)) * HTB)
#define PG8_STAGE(bufoff, gbase, voff) do { _Pragma("unroll") for (int _i = 0; _i < 2; ++_i) \
        __builtin_amdgcn_global_load_lds((const unsigned*)((const char*)(gbase) + (voff)[_i]), (PG8_LAS unsigned*)(lds + (bufoff) + ldsw + _i * 8192), 16, 0, 0); } while (0)
#define PG8_LDA(dst, b, h) do { _Pragma("unroll") for (int m = 0; m < 4; ++m) _Pragma("unroll") for (int k = 0; k < 2; ++k) dst[m][k] = *(const PG8_LAS bf16x8*)(lds + PG8_SA(b, h) + aoff + m * 2048 + k * 1024); } while (0)
#define PG8_LDB(dst, b, h) do { _Pragma("unroll") for (int n = 0; n < 2; ++n) _Pragma("unroll") for (int k = 0; k < 2; ++k) dst[n][k] = *(const PG8_LAS bf16x8*)(lds + PG8_SB(b, h) + boff + n * 2048 + k * 1024); } while (0)
#define PG8_MMA(ai, bj, At, Bt) do { __builtin_amdgcn_s_setprio(1); _Pragma("unroll") for (int m = 0; m < 4; ++m) _Pragma("unroll") for (int n = 0; n < 2; ++n) _Pragma("unroll") for (int k = 0; k < 2; ++k) \
        acc[ai][bj][m][n] = __builtin_amdgcn_mfma_f32_16x16x32_bf16(Bt[n][k], At[m][k], acc[ai][bj][m][n], 0, 0, 0); __builtin_amdgcn_s_setprio(0); } while (0)
#define PG8_WAIT_V(n) asm volatile("s_waitcnt vmcnt(" #n ")" ::: "memory")
#define PG8_WAIT_L(n) asm volatile("s_waitcnt lgkmcnt(" #n ")" ::: "memory")
#define PG8_BAR __builtin_amdgcn_s_barrier()
#define PG8_SCHED __builtin_amdgcn_sched_barrier(0)
    Unit cur, nxt; int ui = 0;
    if (!S.next(0, cur)) return;
    f32x4 acc[2][2][4][2];
#pragma unroll
    for (int a = 0; a < 2; ++a)
#pragma unroll
        for (int b = 0; b < 2; ++b)
#pragma unroll
            for (int m = 0; m < 4; ++m)
#pragma unroll
                for (int n = 0; n < 2; ++n) acc[a][b][m][n] = (f32x4){0.f, 0.f, 0.f, 0.f};
    bf16x8 At[4][2], B0[2][2], B1[2][2];
    const char* cA = (const char*)g.A + (size_t)cur.pm * tstep; const char* cB = (const char*)g.Bt + (size_t)cur.pn * tstep;
    S.a_ready(cur);
    if constexpr (SP2) {
        PG8_STAGE(PG8_SB(0, 0), cB, voffB); PG8_STAGE(PG8_SB(0, 1), cB + hstep, voffB); PG8_STAGE(PG8_SA(0, 0), cA, voffA); PG8_STAGE(PG8_SA(0, 1), cA + hstep, voffA);
        if (wr == 1) PG8_BAR;
        PG8_WAIT_V(2); PG8_BAR;
        PG8_STAGE(PG8_SB(1, 0), cB + kstep, voffB); PG8_STAGE(PG8_SA(1, 0), cA + kstep, voffA); PG8_STAGE(PG8_SB(1, 1), cB + hstep + kstep, voffB);
        PG8_WAIT_V(6); PG8_BAR;
    } else {
        PG8_STAGE(PG8_SB(0, 0), cB, voffB); PG8_STAGE(PG8_SA(0, 0), cA, voffA); PG8_STAGE(PG8_SB(0, 1), cB + hstep, voffB); PG8_STAGE(PG8_SA(0, 1), cA + hstep, voffA);
        if (wr == 1) PG8_BAR;
        PG8_WAIT_V(4); PG8_BAR;
        PG8_STAGE(PG8_SB(1, 0), cB + kstep, voffB); PG8_STAGE(PG8_SA(1, 0), cA + kstep, voffA); PG8_STAGE(PG8_SB(1, 1), cB + hstep + kstep, voffB);
        PG8_WAIT_V(6); PG8_BAR;
    }
    for (;;) {
        const bool has_next = S.next(ui + 1, nxt);
        const char* nA = has_next ? (const char*)g.A + (size_t)nxt.pm * tstep : cA; const char* nB = has_next ? (const char*)g.Bt + (size_t)nxt.pn * tstep : cB;
        for (int t = 0; t < nt; t += 2) {
            const bool last = (t == nt - 2);
            const char* a1 = cA + (size_t)(t + 1) * kstep;
            const char* a2 = last ? nA : cA + (size_t)(t + 2) * kstep; const char* b2 = last ? nB : cB + (size_t)(t + 2) * kstep;
            const char* a3 = a2 + kstep; const char* b3 = b2 + kstep;
            if (last && has_next) S.a_ready(nxt);
            if constexpr (SP2) {
            PG8_LDB(B0, 0, 0); PG8_LDB(B1, 0, 1); PG8_SCHED; PG8_LDA(At, 0, 0); PG8_STAGE(PG8_SA(1, 1), a1 + hstep, voffA);
            PG8_WAIT_V(8); PG8_WAIT_L(0); PG8_BAR; PG8_MMA(0, 0, At, B0); PG8_MMA(0, 1, At, B1); PG8_BAR; PG8_SCHED;
            PG8_LDA(At, 0, 1); PG8_STAGE(PG8_SB(0, 0), b2, voffB); PG8_STAGE(PG8_SB(0, 1), b2 + hstep, voffB); PG8_STAGE(PG8_SA(0, 0), a2, voffA);
            PG8_WAIT_V(8); PG8_WAIT_L(0); PG8_BAR; PG8_MMA(1, 0, At, B0); PG8_MMA(1, 1, At, B1); PG8_BAR; PG8_SCHED;
            PG8_LDB(B0, 1, 0); PG8_LDB(B1, 1, 1); PG8_SCHED; PG8_LDA(At, 1, 0); PG8_STAGE(PG8_SA(0, 1), a2 + hstep, voffA);
            PG8_WAIT_V(8); PG8_WAIT_L(0); PG8_BAR; PG8_MMA(0, 0, At, B0); PG8_MMA(0, 1, At, B1); PG8_BAR; PG8_SCHED;
            PG8_LDA(At, 1, 1); PG8_STAGE(PG8_SB(1, 0), b3, voffB); PG8_STAGE(PG8_SB(1, 1), b3 + hstep, voffB); PG8_STAGE(PG8_SA(1, 0), a3, voffA);
            PG8_WAIT_V(8); PG8_WAIT_L(0); PG8_BAR; PG8_MMA(1, 0, At, B0); PG8_MMA(1, 1, At, B1); PG8_BAR; PG8_SCHED;
            } else {
            PG8_LDB(B0, 0, 0); PG8_SCHED; PG8_LDA(At, 0, 0); PG8_STAGE(PG8_SA(1, 1), a1 + hstep, voffA);
            PG8_WAIT_L(8); PG8_BAR; PG8_WAIT_L(0); PG8_MMA(0, 0, At, B0); PG8_BAR; PG8_SCHED;
            PG8_LDB(B1, 0, 1); PG8_STAGE(PG8_SB(0, 0), b2, voffB);
            PG8_BAR; PG8_WAIT_L(0); PG8_MMA(0, 1, At, B1); PG8_BAR;
            PG8_LDA(At, 0, 1); PG8_STAGE(PG8_SA(0, 0), a2, voffA);
            PG8_BAR; PG8_WAIT_L(0); PG8_MMA(1, 0, At, B0); PG8_BAR; PG8_SCHED;
            PG8_STAGE(PG8_SB(0, 1), b2 + hstep, voffB);
            PG8_WAIT_V(6); PG8_BAR; PG8_MMA(1, 1, At, B1); PG8_BAR;
            PG8_LDB(B0, 1, 0); PG8_SCHED; PG8_LDA(At, 1, 0); PG8_STAGE(PG8_SA(0, 1), a2 + hstep, voffA);
            PG8_WAIT_L(8); PG8_BAR; PG8_WAIT_L(0); PG8_MMA(0, 0, At, B0); PG8_BAR; PG8_SCHED;
            PG8_LDB(B1, 1, 1); PG8_STAGE(PG8_SB(1, 0), b3, voffB);
            PG8_BAR; PG8_WAIT_L(0); PG8_MMA(0, 1, At, B1); PG8_BAR;
            PG8_LDA(At, 1, 1); PG8_STAGE(PG8_SA(1, 0), a3, voffA);
            PG8_BAR; PG8_WAIT_L(0); PG8_MMA(1, 0, At, B0); PG8_BAR; PG8_SCHED;
            PG8_STAGE(PG8_SB(1, 1), b3 + hstep, voffB);
            PG8_WAIT_V(6); PG8_BAR; PG8_MMA(1, 1, At, B1); PG8_BAR;
            }
        }
        if constexpr (ALIGN_EPI) { if (wr == 0) PG8_BAR; }
        if constexpr (!Epi::AFTER_DRAIN) { E(acc, cur, wr, wc, fr, fq); S.done(cur); }
        if (!has_next) break;
#pragma unroll
        for (int a = 0; a < 2; ++a)
#pragma unroll
            for (int b = 0; b < 2; ++b)
#pragma unroll
                for (int m = 0; m < 4; ++m)
#pragma unroll
                    for (int n = 0; n < 2; ++n) acc[a][b][m][n] = (f32x4){0.f, 0.f, 0.f, 0.f};
        cur = nxt; cA = nA; cB = nB; ++ui;
        if constexpr (ALIGN_EPI) { if (wr == 1) PG8_BAR; }
    }
    PG8_WAIT_V(0);
    if constexpr (!ALIGN_EPI) { if (wr == 0) PG8_BAR; }
    PG8_BAR;
    if constexpr (Epi::AFTER_DRAIN) { E.fused(acc, cur, wr, wc, fr, fq, lds, wid, lane); S.done(cur); }
#undef PG8_SA
#undef PG8_SB
#undef PG8_STAGE
#undef PG8_LDA
#undef PG8_LDB
#undef PG8_MMA
#undef PG8_WAIT_V
#undef PG8_WAIT_L
#undef PG8_BAR
#undef PG8_SCHED
}
struct Gemm8 { const unsigned char* A; const unsigned char* Bt; int M, N, K; };
typedef int i32x8 __attribute__((ext_vector_type(8)));
typedef int i32x4 __attribute__((ext_vector_type(4)));
template <class Epi, class Sched>
__device__ __forceinline__ void gemm_phase_f8(PG8_LAS unsigned char* lds, const Gemm8 g, const Sched& S, const Epi& E) {
    constexpr bool ALIGN_EPI = true, SP2 = true;
    const int tid = threadIdx.x, wid = __builtin_amdgcn_readfirstlane(tid >> 6), lane = tid & 63, wr = wid >> 2, wc = wid & 3, fr = lane & 15, fq = lane >> 4;
    int K_ = g.K; asm volatile("" : "+s"(K_));
    const int K = K_, nt = K / 128;
    unsigned voffA[2], voffB[2];
#pragma unroll
    for (int i = 0; i < 2; ++i) { int R, C; stage_rc(tid * 16 + i * 8192, R, C); const int Rb = Epi::PERM ? ((R & ~31) + perm32(R & 31)) : R;
        voffA[i] = (unsigned)(R * K + C * 2); voffB[i] = (unsigned)(Rb * K + C * 2); }
    const size_t kstep = (size_t)(BK * 2);
    const size_t hstep = (size_t)HALF * K;
    const size_t tstep = 2 * hstep;
    const unsigned ldsw = (unsigned)wid * 1024u;
    const int aoff = lds_byte(wr * 64 + fr, fq * 8), boff = lds_byte(wc * 32 + fr, fq * 8);
#define PG8_SA(b, h) (((b) * 2 + (h)) * HTB)
#define PG8_SB(b, h) ((4 + (b) * 2 + (h)) * HTB)
#define PG8_STAGE(bufoff, gbase, voff) do { _Pragma("unroll") for (int _i = 0; _i < 2; ++_i) \
        __builtin_amdgcn_global_load_lds((const unsigned*)((const char*)(gbase) + (voff)[_i]), (PG8_LAS unsigned*)(lds + (bufoff) + ldsw + _i * 8192), 16, 0, 0); } while (0)
#define PG8_LDA(dst, b, h) do { _Pragma("unroll") for (int m = 0; m < 4; ++m) { const i32x4 lo_ = *(const PG8_LAS i32x4*)(lds + PG8_SA(b, h) + aoff + m * 2048), hi_ = *(const PG8_LAS i32x4*)(lds + PG8_SA(b, h) + aoff + m * 2048 + 1024); dst[m] = __builtin_shufflevector(lo_, hi_, 0, 1, 2, 3, 4, 5, 6, 7); } } while (0)
#define PG8_LDB(dst, b, h) do { _Pragma("unroll") for (int n = 0; n < 2; ++n) { const i32x4 lo_ = *(const PG8_LAS i32x4*)(lds + PG8_SB(b, h) + boff + n * 2048), hi_ = *(const PG8_LAS i32x4*)(lds + PG8_SB(b, h) + boff + n * 2048 + 1024); dst[n] = __builtin_shufflevector(lo_, hi_, 0, 1, 2, 3, 4, 5, 6, 7); } } while (0)
#define PG8_MMA(ai, bj, At, Bt) do { __builtin_amdgcn_s_setprio(1); _Pragma("unroll") for (int m = 0; m < 4; ++m) _Pragma("unroll") for (int n = 0; n < 2; ++n) \
        asm volatile("v_mfma_f32_16x16x128_f8f6f4 %0, %1, %2, %0" : "+v"(acc[ai][bj][m][n]) : "v"(Bt[n]), "v"(At[m])); __builtin_amdgcn_s_setprio(0); } while (0)
#define PG8_WAIT_V(n) asm volatile("s_waitcnt vmcnt(" #n ")" ::: "memory")
#define PG8_WAIT_L(n) asm volatile("s_waitcnt lgkmcnt(" #n ")" ::: "memory")
#define PG8_BAR __builtin_amdgcn_s_barrier()
#define PG8_SCHED __builtin_amdgcn_sched_barrier(0)
    Unit cur, nxt; int ui = 0;
    if (!S.next(0, cur)) return;
    f32x4 acc[2][2][4][2];
#pragma unroll
    for (int a = 0; a < 2; ++a)
#pragma unroll
        for (int b = 0; b < 2; ++b)
#pragma unroll
            for (int m = 0; m < 4; ++m)
#pragma unroll
                for (int n = 0; n < 2; ++n) acc[a][b][m][n] = (f32x4){0.f, 0.f, 0.f, 0.f};
    i32x8 At[4], B0[2], B1[2];
    const char* cA = (const char*)g.A + (size_t)cur.pm * tstep; const char* cB = (const char*)g.Bt + (size_t)cur.pn * tstep;
    S.a_ready(cur);
    if constexpr (SP2) {
        PG8_STAGE(PG8_SB(0, 0), cB, voffB); PG8_STAGE(PG8_SB(0, 1), cB + hstep, voffB); PG8_STAGE(PG8_SA(0, 0), cA, voffA); PG8_STAGE(PG8_SA(0, 1), cA + hstep, voffA);
        if (wr == 1) PG8_BAR;
        PG8_WAIT_V(2); PG8_BAR;
        PG8_STAGE(PG8_SB(1, 0), cB + kstep, voffB); PG8_STAGE(PG8_SA(1, 0), cA + kstep, voffA); PG8_STAGE(PG8_SB(1, 1), cB + hstep + kstep, voffB);
        PG8_WAIT_V(6); PG8_BAR;
    } else {
        PG8_STAGE(PG8_SB(0, 0), cB, voffB); PG8_STAGE(PG8_SA(0, 0), cA, voffA); PG8_STAGE(PG8_SB(0, 1), cB + hstep, voffB); PG8_STAGE(PG8_SA(0, 1), cA + hstep, voffA);
        if (wr == 1) PG8_BAR;
        PG8_WAIT_V(4); PG8_BAR;
        PG8_STAGE(PG8_SB(1, 0), cB + kstep, voffB); PG8_STAGE(PG8_SA(1, 0), cA + kstep, voffA); PG8_STAGE(PG8_SB(1, 1), cB + hstep + kstep, voffB);
        PG8_WAIT_V(6); PG8_BAR;
    }
    for (;;) {
        const bool has_next = S.next(ui + 1, nxt);
        const char* nA = has_next ? (const char*)g.A + (size_t)nxt.pm * tstep : cA; const char* nB = has_next ? (const char*)g.Bt + (size_t)nxt.pn * tstep : cB;
#pragma unroll 1
        for (int t = 0; t < nt; t += 2) {
            const bool last = (t == nt - 2);
            const char* a1 = cA + (size_t)(t + 1) * kstep;
            const char* a2 = last ? nA : cA + (size_t)(t + 2) * kstep; const char* b2 = last ? nB : cB + (size_t)(t + 2) * kstep;
            const char* a3 = a2 + kstep; const char* b3 = b2 + kstep;
            if (last && has_next) S.a_ready(nxt);
            if constexpr (SP2) {
            PG8_LDB(B0, 0, 0); PG8_LDB(B1, 0, 1); PG8_SCHED; PG8_LDA(At, 0, 0); PG8_STAGE(PG8_SA(1, 1), a1 + hstep, voffA);
            PG8_WAIT_V(8); PG8_WAIT_L(0); PG8_BAR; PG8_MMA(0, 0, At, B0); PG8_MMA(0, 1, At, B1); PG8_BAR; PG8_SCHED;
            PG8_LDA(At, 0, 1); PG8_STAGE(PG8_SB(0, 0), b2, voffB); PG8_STAGE(PG8_SB(0, 1), b2 + hstep, voffB); PG8_STAGE(PG8_SA(0, 0), a2, voffA);
            PG8_WAIT_V(8); PG8_WAIT_L(0); PG8_BAR; PG8_MMA(1, 0, At, B0); PG8_MMA(1, 1, At, B1); PG8_BAR; PG8_SCHED;
            PG8_LDB(B0, 1, 0); PG8_LDB(B1, 1, 1); PG8_SCHED; PG8_LDA(At, 1, 0); PG8_STAGE(PG8_SA(0, 1), a2 + hstep, voffA);
            PG8_WAIT_V(8); PG8_WAIT_L(0); PG8_BAR; PG8_MMA(0, 0, At, B0); PG8_MMA(0, 1, At, B1); PG8_BAR; PG8_SCHED;
            PG8_LDA(At, 1, 1); PG8_STAGE(PG8_SB(1, 0), b3, voffB); PG8_STAGE(PG8_SB(1, 1), b3 + hstep, voffB); PG8_STAGE(PG8_SA(1, 0), a3, voffA);
            PG8_WAIT_V(8); PG8_WAIT_L(0); PG8_BAR; PG8_MMA(1, 0, At, B0); PG8_MMA(1, 1, At, B1); PG8_BAR; PG8_SCHED;
            } else {
            PG8_LDB(B0, 0, 0); PG8_SCHED; PG8_LDA(At, 0, 0); PG8_STAGE(PG8_SA(1, 1), a1 + hstep, voffA);
            PG8_WAIT_L(8); PG8_BAR; PG8_WAIT_L(0); PG8_MMA(0, 0, At, B0); PG8_BAR; PG8_SCHED;
            PG8_LDB(B1, 0, 1); PG8_STAGE(PG8_SB(0, 0), b2, voffB);
            PG8_BAR; PG8_WAIT_L(0); PG8_MMA(0, 1, At, B1); PG8_BAR;
            PG8_LDA(At, 0, 1); PG8_STAGE(PG8_SA(0, 0), a2, voffA);
            PG8_BAR; PG8_WAIT_L(0); PG8_MMA(1, 0, At, B0); PG8_BAR; PG8_SCHED;
            PG8_STAGE(PG8_SB(0, 1), b2 + hstep, voffB);
            PG8_WAIT_V(6); PG8_BAR; PG8_MMA(1, 1, At, B1); PG8_BAR;
            PG8_LDB(B0, 1, 0); PG8_SCHED; PG8_LDA(At, 1, 0); PG8_STAGE(PG8_SA(0, 1), a2 + hstep, voffA);
            PG8_WAIT_L(8); PG8_BAR; PG8_WAIT_L(0); PG8_MMA(0, 0, At, B0); PG8_BAR; PG8_SCHED;
            PG8_LDB(B1, 1, 1); PG8_STAGE(PG8_SB(1, 0), b3, voffB);
            PG8_BAR; PG8_WAIT_L(0); PG8_MMA(0, 1, At, B1); PG8_BAR;
            PG8_LDA(At, 1, 1); PG8_STAGE(PG8_SA(1, 0), a3, voffA);
            PG8_BAR; PG8_WAIT_L(0); PG8_MMA(1, 0, At, B0); PG8_BAR; PG8_SCHED;
            PG8_STAGE(PG8_SB(1, 1), b3 + hstep, voffB);
            PG8_WAIT_V(6); PG8_BAR; PG8_MMA(1, 1, At, B1); PG8_BAR;
            }
        }
        if constexpr (ALIGN_EPI) { if (wr == 0) PG8_BAR; }
        asm volatile("s_nop 15\n\ts_nop 15" ::: "memory");
#pragma unroll
        for (int a_ = 0; a_ < 2; ++a_)
#pragma unroll
            for (int b_ = 0; b_ < 2; ++b_)
                asm volatile("" : "+v"(acc[a_][b_][0][0]), "+v"(acc[a_][b_][0][1]), "+v"(acc[a_][b_][1][0]), "+v"(acc[a_][b_][1][1]), "+v"(acc[a_][b_][2][0]), "+v"(acc[a_][b_][2][1]), "+v"(acc[a_][b_][3][0]), "+v"(acc[a_][b_][3][1]));
        if constexpr (!Epi::AFTER_DRAIN) { E(acc, cur, wr, wc, fr, fq); S.done(cur); }
        if (!has_next) break;
#pragma unroll
        for (int a = 0; a < 2; ++a)
#pragma unroll
            for (int b = 0; b < 2; ++b)
#pragma unroll
                for (int m = 0; m < 4; ++m)
#pragma unroll
                    for (int n = 0; n < 2; ++n) acc[a][b][m][n] = (f32x4){0.f, 0.f, 0.f, 0.f};
        cur = nxt; cA = nA; cB = nB; ++ui;
        if constexpr (ALIGN_EPI) { if (wr == 1) PG8_BAR; }
    }
    PG8_WAIT_V(0);
    if constexpr (!ALIGN_EPI) { if (wr == 0) PG8_BAR; }
    PG8_BAR;
    if constexpr (Epi::AFTER_DRAIN) { E.fused(acc, cur, wr, wc, fr, fq, lds, wid, lane); S.done(cur); }
#undef PG8_SA
#undef PG8_SB
#undef PG8_STAGE
#undef PG8_LDA
#undef PG8_LDB
#undef PG8_MMA
#undef PG8_WAIT_V
#undef PG8_WAIT_L
#undef PG8_BAR
#undef PG8_SCHED
}
template <class Epi, class Sched>
__device__ __forceinline__ void gemm_phase_i8(PG8_LAS unsigned char* lds, const Gemm8 g, const Sched& S, const Epi& E) {
    constexpr bool ALIGN_EPI = true, SP2 = true;
    const int tid = threadIdx.x, wid = __builtin_amdgcn_readfirstlane(tid >> 6), lane = tid & 63, wr = wid >> 2, wc = wid & 3, fr = lane & 15, fq = lane >> 4;
    int K_ = g.K; asm volatile("" : "+s"(K_));
    const int K = K_, nt = K / 128;
    unsigned voffA[2], voffB[2];
#pragma unroll
    for (int i = 0; i < 2; ++i) { int R, C; stage_rc(tid * 16 + i * 8192, R, C); const int Rb = Epi::PERM ? ((R & ~31) + perm32(R & 31)) : R;
        voffA[i] = (unsigned)(R * K + C * 2); voffB[i] = (unsigned)(Rb * K + C * 2); }
    const size_t kstep = (size_t)(BK * 2);
    const size_t hstep = (size_t)HALF * K;
    const size_t tstep = 2 * hstep;
    const unsigned ldsw = (unsigned)wid * 1024u;
    const int aoff = lds_byte(wr * 64 + fr, fq * 8), boff = lds_byte(wc * 32 + fr, fq * 8);
#define PG8_SA(b, h) (((b) * 2 + (h)) * HTB)
#define PG8_SB(b, h) ((4 + (b) * 2 + (h)) * HTB)
#define PG8_STAGE(bufoff, gbase, voff) do { _Pragma("unroll") for (int _i = 0; _i < 2; ++_i) \
        __builtin_amdgcn_global_load_lds((const unsigned*)((const char*)(gbase) + (voff)[_i]), (PG8_LAS unsigned*)(lds + (bufoff) + ldsw + _i * 8192), 16, 0, 0); } while (0)
#define PG8_LDA(dst, b, h) do { _Pragma("unroll") for (int m = 0; m < 4; ++m) _Pragma("unroll") for (int k = 0; k < 2; ++k) dst[m][k] = *(const PG8_LAS i32x4*)(lds + PG8_SA(b, h) + aoff + m * 2048 + k * 1024); } while (0)
#define PG8_LDB(dst, b, h) do { _Pragma("unroll") for (int n = 0; n < 2; ++n) _Pragma("unroll") for (int k = 0; k < 2; ++k) dst[n][k] = *(const PG8_LAS i32x4*)(lds + PG8_SB(b, h) + boff + n * 2048 + k * 1024); } while (0)
#define PG8_MMA(ai, bj, At, Bt) do { __builtin_amdgcn_s_setprio(1); _Pragma("unroll") for (int m = 0; m < 4; ++m) _Pragma("unroll") for (int n = 0; n < 2; ++n) _Pragma("unroll") for (int k = 0; k < 2; ++k) \
        acc[ai][bj][m][n] = __builtin_amdgcn_mfma_i32_16x16x64_i8(Bt[n][k], At[m][k], acc[ai][bj][m][n], 0, 0, 0); __builtin_amdgcn_s_setprio(0); } while (0)
#define PG8_WAIT_V(n) asm volatile("s_waitcnt vmcnt(" #n ")" ::: "memory")
#define PG8_WAIT_L(n) asm volatile("s_waitcnt lgkmcnt(" #n ")" ::: "memory")
#define PG8_BAR __builtin_amdgcn_s_barrier()
#define PG8_SCHED __builtin_amdgcn_sched_barrier(0)
    Unit cur, nxt; int ui = 0;
    if (!S.next(0, cur)) return;
    i32x4 acc[2][2][4][2];
#pragma unroll
    for (int a = 0; a < 2; ++a)
#pragma unroll
        for (int b = 0; b < 2; ++b)
#pragma unroll
            for (int m = 0; m < 4; ++m)
#pragma unroll
                for (int n = 0; n < 2; ++n) acc[a][b][m][n] = (i32x4){0, 0, 0, 0};
    i32x4 At[4][2], B0[2][2], B1[2][2];
    const char* cA = (const char*)g.A + (size_t)cur.pm * tstep; const char* cB = (const char*)g.Bt + (size_t)cur.pn * tstep;
    S.a_ready(cur);
    if constexpr (SP2) {
        PG8_STAGE(PG8_SB(0, 0), cB, voffB); PG8_STAGE(PG8_SB(0, 1), cB + hstep, voffB); PG8_STAGE(PG8_SA(0, 0), cA, voffA); PG8_STAGE(PG8_SA(0, 1), cA + hstep, voffA);
        if (wr == 1) PG8_BAR;
        PG8_WAIT_V(2); PG8_BAR;
        PG8_STAGE(PG8_SB(1, 0), cB + kstep, voffB); PG8_STAGE(PG8_SA(1, 0), cA + kstep, voffA); PG8_STAGE(PG8_SB(1, 1), cB + hstep + kstep, voffB);
        PG8_WAIT_V(6); PG8_BAR;
    } else {
        PG8_STAGE(PG8_SB(0, 0), cB, voffB); PG8_STAGE(PG8_SA(0, 0), cA, voffA); PG8_STAGE(PG8_SB(0, 1), cB + hstep, voffB); PG8_STAGE(PG8_SA(0, 1), cA + hstep, voffA);
        if (wr == 1) PG8_BAR;
        PG8_WAIT_V(4); PG8_BAR;
        PG8_STAGE(PG8_SB(1, 0), cB + kstep, voffB); PG8_STAGE(PG8_SA(1, 0), cA + kstep, voffA); PG8_STAGE(PG8_SB(1, 1), cB + hstep + kstep, voffB);
        PG8_WAIT_V(6); PG8_BAR;
    }
    for (;;) {
        const bool has_next = S.next(ui + 1, nxt);
        const char* nA = has_next ? (const char*)g.A + (size_t)nxt.pm * tstep : cA; const char* nB = has_next ? (const char*)g.Bt + (size_t)nxt.pn * tstep : cB;
#pragma unroll 1
        for (int t = 0; t < nt; t += 2) {
            const bool last = (t == nt - 2);
            const char* a1 = cA + (size_t)(t + 1) * kstep;
            const char* a2 = last ? nA : cA + (size_t)(t + 2) * kstep; const char* b2 = last ? nB : cB + (size_t)(t + 2) * kstep;
            const char* a3 = a2 + kstep; const char* b3 = b2 + kstep;
            if (last && has_next) S.a_ready(nxt);
            if constexpr (SP2) {
            PG8_LDB(B0, 0, 0); PG8_LDB(B1, 0, 1); PG8_SCHED; PG8_LDA(At, 0, 0); PG8_STAGE(PG8_SA(1, 1), a1 + hstep, voffA);
            PG8_WAIT_V(8); PG8_WAIT_L(0); PG8_BAR; PG8_MMA(0, 0, At, B0); PG8_MMA(0, 1, At, B1); PG8_BAR; PG8_SCHED;
            PG8_LDA(At, 0, 1); PG8_STAGE(PG8_SB(0, 0), b2, voffB); PG8_STAGE(PG8_SB(0, 1), b2 + hstep, voffB); PG8_STAGE(PG8_SA(0, 0), a2, voffA);
            PG8_WAIT_V(8); PG8_WAIT_L(0); PG8_BAR; PG8_MMA(1, 0, At, B0); PG8_MMA(1, 1, At, B1); PG8_BAR; PG8_SCHED;
            PG8_LDB(B0, 1, 0); PG8_LDB(B1, 1, 1); PG8_SCHED; PG8_LDA(At, 1, 0); PG8_STAGE(PG8_SA(0, 1), a2 + hstep, voffA);
            PG8_WAIT_V(8); PG8_WAIT_L(0); PG8_BAR; PG8_MMA(0, 0, At, B0); PG8_MMA(0, 1, At, B1); PG8_BAR; PG8_SCHED;
            PG8_LDA(At, 1, 1); PG8_STAGE(PG8_SB(1, 0), b3, voffB); PG8_STAGE(PG8_SB(1, 1), b3 + hstep, voffB); PG8_STAGE(PG8_SA(1, 0), a3, voffA);
            PG8_WAIT_V(8); PG8_WAIT_L(0); PG8_BAR; PG8_MMA(1, 0, At, B0); PG8_MMA(1, 1, At, B1); PG8_BAR; PG8_SCHED;
            } else {
            PG8_LDB(B0, 0, 0); PG8_SCHED; PG8_LDA(At, 0, 0); PG8_STAGE(PG8_SA(1, 1), a1 + hstep, voffA);
            PG8_WAIT_L(8); PG8_BAR; PG8_WAIT_L(0); PG8_MMA(0, 0, At, B0); PG8_BAR; PG8_SCHED;
            PG8_LDB(B1, 0, 1); PG8_STAGE(PG8_SB(0, 0), b2, voffB);
            PG8_BAR; PG8_WAIT_L(0); PG8_MMA(0, 1, At, B1); PG8_BAR;
            PG8_LDA(At, 0, 1); PG8_STAGE(PG8_SA(0, 0), a2, voffA);
            PG8_BAR; PG8_WAIT_L(0); PG8_MMA(1, 0, At, B0); PG8_BAR; PG8_SCHED;
            PG8_STAGE(PG8_SB(0, 1), b2 + hstep, voffB);
            PG8_WAIT_V(6); PG8_BAR; PG8_MMA(1, 1, At, B1); PG8_BAR;
            PG8_LDB(B0, 1, 0); PG8_SCHED; PG8_LDA(At, 1, 0); PG8_STAGE(PG8_SA(0, 1), a2 + hstep, voffA);
            PG8_WAIT_L(8); PG8_BAR; PG8_WAIT_L(0); PG8_MMA(0, 0, At, B0); PG8_BAR; PG8_SCHED;
            PG8_LDB(B1, 1, 1); PG8_STAGE(PG8_SB(1, 0), b3, voffB);
            PG8_BAR; PG8_WAIT_L(0); PG8_MMA(0, 1, At, B1); PG8_BAR;
            PG8_LDA(At, 1, 1); PG8_STAGE(PG8_SA(1, 0), a3, voffA);
            PG8_BAR; PG8_WAIT_L(0); PG8_MMA(1, 0, At, B0); PG8_BAR; PG8_SCHED;
            PG8_STAGE(PG8_SB(1, 1), b3 + hstep, voffB);
            PG8_WAIT_V(6); PG8_BAR; PG8_MMA(1, 1, At, B1); PG8_BAR;
            }
        }
        if constexpr (ALIGN_EPI) { if (wr == 0) PG8_BAR; }
        if constexpr (!Epi::AFTER_DRAIN) { E(acc, cur, wr, wc, fr, fq); S.done(cur); }
        if (!has_next) break;
#pragma unroll
        for (int a = 0; a < 2; ++a)
#pragma unroll
            for (int b = 0; b < 2; ++b)
#pragma unroll
                for (int m = 0; m < 4; ++m)
#pragma unroll
                    for (int n = 0; n < 2; ++n) acc[a][b][m][n] = (i32x4){0, 0, 0, 0};
        cur = nxt; cA = nA; cB = nB; ++ui;
        if constexpr (ALIGN_EPI) { if (wr == 1) PG8_BAR; }
    }
    PG8_WAIT_V(0);
    if constexpr (!ALIGN_EPI) { if (wr == 0) PG8_BAR; }
    PG8_BAR;
    if constexpr (Epi::AFTER_DRAIN) { E.fused(acc, cur, wr, wc, fr, fq, lds, wid, lane); S.done(cur); }
#undef PG8_SA
#undef PG8_SB
#undef PG8_STAGE
#undef PG8_LDA
#undef PG8_LDB
#undef PG8_MMA
#undef PG8_WAIT_V
#undef PG8_WAIT_L
#undef PG8_BAR
#undef PG8_SCHED
}
}
constexpr int BATCH = 8, SEQ = 2048, DM = 1024, T = BATCH * SEQ;
constexpr int INW = 5888;
constexpr float EPS = 1e-6f;
constexpr size_t MiB = 1u << 20;
constexpr size_t WS_CTL = 0, CTL_ZERO_BYTES = 64 * 1024;
constexpr size_t WS_TAB = 1 * MiB;
constexpr size_t WS_K1 = 13 * MiB + 512 * 1024, WS_K2 = WS_K1 + 65536;
constexpr size_t WS_WIN = 2 * MiB, WS_WA = 14 * MiB  , WS_WR = 16 * MiB, WS_WO = 18 * MiB, WS_WQ = 20 * MiB;
constexpr size_t WS_QA = 24 * MiB, WS_KVA = 40 * MiB, WS_QR = 48 * MiB, WS_KR = 64 * MiB, WS_VR = 80 * MiB, WS_GR = 112 * MiB, WS_GA = 144 * MiB;
constexpr size_t WS_U4 = 200 * MiB, WS_V4 = 208 * MiB;
constexpr size_t WS_SU = WS_TAB + 768 * 1024, WS_SV = WS_SU + 65536;
constexpr size_t WS_SS2 = WS_SV + 65536;
constexpr size_t WS_HN8 = 176 * MiB, WS_WIN8 = 192 * MiB, WS_CSC = 198 * MiB  , WS_RSC = WS_TAB + 960 * 1024  ;
constexpr size_t WS_ATT = 216 * MiB;
constexpr size_t WS_RET = 160 * MiB  , WS_MERGED = WS_QA, WS_HN2 = WS_GR, WS_PQ = WS_QA  , WS_IDX = 88 * MiB, WS_GATE = 96 * MiB;
constexpr size_t DO_HN = 0, DO_KVT = 0  , DO_YA = 0  , DO_GT = 32 * MiB;
constexpr int CW_BAR = 4096;
namespace pg8 {
typedef unsigned u32x2 __attribute__((ext_vector_type(2)));
__device__ __forceinline__ float sigm(float g) { return 1.0f / (1.0f + __expf(-g)); }
__device__ __forceinline__ float bflo(unsigned w) { return __builtin_bit_cast(float, w << 16); }
__device__ __forceinline__ float bfhi(unsigned w) { return __builtin_bit_cast(float, w & 0xffff0000u); }
struct EpiProj {
    static constexpr bool PERM = true, AFTER_DRAIN = false;
    unsigned char* ws; unsigned char* gt;
    __device__ __forceinline__ void operator()(const f32x4 (&acc)[2][2][4][2], const Unit& u, int wr, int wc, int fr, int fq) const {
        const int pn = u.pn; size_t off = 0; int ld, ct;
        if (pn < 2) { off = WS_QA; ld = 512; ct = pn; } else if (pn < 3) { off = WS_KVA; ld = 256; ct = 0; } else if (pn < 5) { off = WS_QR; ld = 512; ct = pn - 3; }
        else if (pn < 7) { off = WS_KR; ld = 512; ct = pn - 5; } else if (pn < 11) { off = WS_VR; ld = 1024; ct = pn - 7; } else if (pn < 15) { off = WS_GR; ld = 1024; ct = pn - 11; }
        else if (pn < 19) { off = WS_GA; ld = 1024; ct = pn - 15; } else { ld = 1024; ct = pn - 19; }
        bf16_t* base = pn < 19 ? (bf16_t*)(ws + off) : (bf16_t*)gt;
        const int row0 = u.pm * BM + wr * 64 + fr, col0 = ct * 256 + wc * 32 + 8 * fq;
#pragma unroll
        for (int ai = 0; ai < 2; ++ai)
#pragma unroll
            for (int m = 0; m < 4; ++m) { bf16_t* rowp = base + (size_t)(row0 + ai * HALF + m * 16) * ld + col0;
#pragma unroll
                for (int bj = 0; bj < 2; ++bj) { const f32x4 v0 = acc[ai][bj][m][0], v1 = acc[ai][bj][m][1];
                    u32x4 w; w.x = cvt_pk_bf16(v0[0], v0[1]); w.y = cvt_pk_bf16(v0[2], v0[3]); w.z = cvt_pk_bf16(v1[0], v1[1]); w.w = cvt_pk_bf16(v1[2], v1[3]);
                    *(u32x4*)(rowp + bj * HALF) = w; } }
    }
};

struct MapOrder {
    StaticOrder S; int f8;
    __device__ bool next(int i, Unit& u) const { if (!S.next(i, u)) return false; u.pn = f8 ? (u.pn < 3 ? u.pn : u.pn + 4) : u.pn + 3; return true; }
    __device__ __forceinline__ void a_ready(const Unit&) const {}
    __device__ __forceinline__ void done(const Unit&) const {}
};
struct EpiProj8 {
    static constexpr bool PERM = true, AFTER_DRAIN = false;
    unsigned char* ws; unsigned char* gt;
    __device__ __forceinline__ void operator()(const f32x4 (&acc)[2][2][4][2], const Unit& u, int wr, int wc, int fr, int fq) const {
        const int j = u.pn; size_t off = 0; int ld, ct;
        if (j < 2) { off = WS_QA; ld = 512; ct = j; } else if (j < 3) { off = WS_KVA; ld = 256; ct = 0; } else if (j < 7) { off = WS_VR; ld = 1024; ct = j - 3; }
        else if (j < 11) { off = WS_GR; ld = 1024; ct = j - 7; } else if (j < 15) { off = WS_GA; ld = 1024; ct = j - 11; } else { ld = 1024; ct = j - 15; }
        bf16_t* base = j < 15 ? (bf16_t*)(ws + off) : (bf16_t*)gt;
        const int row0 = u.pm * BM + wr * 64 + fr, col0 = ct * 256 + wc * 32 + 8 * fq;
        constexpr float SC = 1.0f / 8192.0f;
        if (j >= 11) {
            unsigned char* b8 = (unsigned char*)base;
#pragma unroll
            for (int ai = 0; ai < 2; ++ai)
#pragma unroll
                for (int m = 0; m < 4; ++m) { unsigned char* rowp = b8 + (size_t)(row0 + ai * HALF + m * 16) * 1024 + col0;
#pragma unroll
                    for (int bj = 0; bj < 2; ++bj) { const f32x4 v0 = acc[ai][bj][m][0] * SC, v1 = acc[ai][bj][m][1] * SC;
                        int q0 = __builtin_amdgcn_cvt_pk_fp8_f32(v0[0], v0[1], 0, false); q0 = __builtin_amdgcn_cvt_pk_fp8_f32(v0[2], v0[3], q0, true);
                        int q1 = __builtin_amdgcn_cvt_pk_fp8_f32(v1[0], v1[1], 0, false); q1 = __builtin_amdgcn_cvt_pk_fp8_f32(v1[2], v1[3], q1, true);
                        *(u32x2*)(rowp + bj * HALF) = (u32x2){(unsigned)q0, (unsigned)q1}; } }
            return;
        }
#pragma unroll
        for (int ai = 0; ai < 2; ++ai)
#pragma unroll
            for (int m = 0; m < 4; ++m) { bf16_t* rowp = base + (size_t)(row0 + ai * HALF + m * 16) * ld + col0;
#pragma unroll
                for (int bj = 0; bj < 2; ++bj) { const f32x4 v0 = acc[ai][bj][m][0] * SC, v1 = acc[ai][bj][m][1] * SC;
                    u32x4 w; w.x = cvt_pk_bf16(v0[0], v0[1]); w.y = cvt_pk_bf16(v0[2], v0[3]); w.z = cvt_pk_bf16(v1[0], v1[1]); w.w = cvt_pk_bf16(v1[2], v1[3]);
                    *(u32x4*)(rowp + bj * HALF) = w; } }
    }
};

struct EpiProjI8 {
    static constexpr bool PERM = true, AFTER_DRAIN = false;
    unsigned char* ws; unsigned char* gt; const float* rs; const float* cs;
    __device__ __forceinline__ void operator()(const i32x4 (&acc)[2][2][4][2], const Unit& u, int wr, int wc, int fr, int fq) const {
        const int pn = u.pn; size_t off = 0; int ld, ct;
        if (pn < 2) { off = WS_QA; ld = 512; ct = pn; } else if (pn < 3) { off = WS_KVA; ld = 256; ct = 0; } else if (pn < 5) { off = WS_QR; ld = 512; ct = pn - 3; }
        else if (pn < 7) { off = WS_KR; ld = 512; ct = pn - 5; } else if (pn < 11) { off = WS_VR; ld = 1024; ct = pn - 7; } else if (pn < 15) { off = WS_GR; ld = 1024; ct = pn - 11; }
        else if (pn < 19) { off = WS_GA; ld = 1024; ct = pn - 15; } else { ld = 1024; ct = pn - 19; }
        unsigned char* base = pn < 19 ? ws + off : gt;
        const int row0 = u.pm * BM + wr * 64 + fr, col0 = ct * 256 + wc * 32 + 8 * fq;
        f32x4 c4[2][2];
        { const float* cp = cs + pn * 256 + wc * 32 + 8 * fq;
#pragma unroll
          for (int bj = 0; bj < 2; ++bj) { c4[bj][0] = *(const f32x4*)(cp + bj * HALF); c4[bj][1] = *(const f32x4*)(cp + bj * HALF + 4); } }
#pragma unroll
        for (int ai = 0; ai < 2; ++ai)
#pragma unroll
            for (int m = 0; m < 4; ++m) { const int row = row0 + ai * HALF + m * 16; const float r = rs[row];
#pragma unroll
                for (int bj = 0; bj < 2; ++bj) {
                    const i32x4 a0 = acc[ai][bj][m][0], a1 = acc[ai][bj][m][1];
                    const f32x4 v0 = (f32x4){(float)a0[0], (float)a0[1], (float)a0[2], (float)a0[3]} * (c4[bj][0] * r), v1 = (f32x4){(float)a1[0], (float)a1[1], (float)a1[2], (float)a1[3]} * (c4[bj][1] * r);
                    if (pn >= 15) {
                        int q0 = __builtin_amdgcn_cvt_pk_fp8_f32(v0[0], v0[1], 0, false); q0 = __builtin_amdgcn_cvt_pk_fp8_f32(v0[2], v0[3], q0, true);
                        int q1 = __builtin_amdgcn_cvt_pk_fp8_f32(v1[0], v1[1], 0, false); q1 = __builtin_amdgcn_cvt_pk_fp8_f32(v1[2], v1[3], q1, true);
                        *(u32x2*)(base + (size_t)row * 1024 + col0 + bj * HALF) = (u32x2){(unsigned)q0, (unsigned)q1};
                    } else {
                        u32x4 w; w.x = cvt_pk_bf16(v0[0], v0[1]); w.y = cvt_pk_bf16(v0[2], v0[3]); w.z = cvt_pk_bf16(v1[0], v1[1]); w.w = cvt_pk_bf16(v1[2], v1[3]);
                        *(u32x4*)((bf16_t*)base + (size_t)row * ld + col0 + bj * HALF) = w; } } }
    }
};
struct EpiPlain {
    static constexpr bool PERM = true, AFTER_DRAIN = false;
    bf16_t* O; int ldc;
    __device__ __forceinline__ void operator()(const f32x4 (&acc)[2][2][4][2], const Unit& u, int wr, int wc, int fr, int fq) const {
        const int row0 = u.pm * BM + wr * 64 + fr, col0 = u.pn * BM + wc * 32 + 8 * fq;
#pragma unroll
        for (int ai = 0; ai < 2; ++ai)
#pragma unroll
            for (int m = 0; m < 4; ++m) { bf16_t* rowp = O + (size_t)(row0 + ai * HALF + m * 16) * ldc + col0;
#pragma unroll
                for (int bj = 0; bj < 2; ++bj) { const f32x4 v0 = acc[ai][bj][m][0], v1 = acc[ai][bj][m][1];
                    u32x4 w; w.x = cvt_pk_bf16(v0[0], v0[1]); w.y = cvt_pk_bf16(v0[2], v0[3]); w.z = cvt_pk_bf16(v1[0], v1[1]); w.w = cvt_pk_bf16(v1[2], v1[3]);
                    *(u32x4*)(rowp + bj * HALF) = w; } }
    }
};
template <int MODE> struct EpiGate {
    static constexpr bool PERM = true, AFTER_DRAIN = false;
    const bf16_t* G; const bf16_t* Y; bf16_t* O;
    __device__ __forceinline__ void operator()(const f32x4 (&acc)[2][2][4][2], const Unit& u, int wr, int wc, int fr, int fq) const {
        const int row0 = u.pm * BM + wr * 64 + fr, col0 = u.pn * BM + wc * 32 + 8 * fq;
#pragma unroll
        for (int ai = 0; ai < 2; ++ai)
#pragma unroll
            for (int m = 0; m < 4; ++m) { const size_t ro = (size_t)(row0 + ai * HALF + m * 16) * 1024 + col0;
#pragma unroll
                for (int bj = 0; bj < 2; ++bj) { const f32x4 v0 = acc[ai][bj][m][0], v1 = acc[ai][bj][m][1];
                    const u32x4 g = *(const u32x4*)(G + ro + bj * HALF);
                    float r0 = sigm(bflo(g.x)) * v0[0], r1 = sigm(bfhi(g.x)) * v0[1], r2 = sigm(bflo(g.y)) * v0[2], r3 = sigm(bfhi(g.y)) * v0[3];
                    float r4 = sigm(bflo(g.z)) * v1[0], r5 = sigm(bfhi(g.z)) * v1[1], r6 = sigm(bflo(g.w)) * v1[2], r7 = sigm(bfhi(g.w)) * v1[3];
                    if (MODE == 1) { const u32x4 y = *(const u32x4*)(Y + ro + bj * HALF);
                        r0 += bflo(y.x); r1 += bfhi(y.x); r2 += bflo(y.y); r3 += bfhi(y.y); r4 += bflo(y.z); r5 += bfhi(y.z); r6 += bflo(y.w); r7 += bfhi(y.w); }
                    u32x4 w; w.x = cvt_pk_bf16(r0, r1); w.y = cvt_pk_bf16(r2, r3); w.z = cvt_pk_bf16(r4, r5); w.w = cvt_pk_bf16(r6, r7);
                    *(u32x4*)(O + ro + bj * HALF) = w; } }
    }
};
struct EpiResid {
    static constexpr bool PERM = false, AFTER_DRAIN = false;
    const float* x; float* h;
    __device__ __forceinline__ void operator()(const f32x4 (&acc)[2][2][4][2], const Unit& u, int wr, int wc, int fr, int fq) const {
        const int col0 = u.pn * BM + wc * 32 + 4 * fq;
#pragma unroll
        for (int ai = 0; ai < 2; ++ai)
#pragma unroll
            for (int m = 0; m < 4; ++m) { const size_t off = (size_t)(u.pm * BM + ai * HALF + wr * 64 + m * 16 + fr) * 1024 + col0;
#pragma unroll
                for (int bj = 0; bj < 2; ++bj)
#pragma unroll
                    for (int n = 0; n < 2; ++n) *(f32x4*)(h + off + bj * HALF + n * 16) = *(const f32x4*)(x + off + bj * HALF + n * 16) + acc[ai][bj][m][n]; }
    }
};
struct EpiResid2 {
    static constexpr bool PERM = false, AFTER_DRAIN = false;
    const float* x; float* h; bf16_t* hg; const float* gain; float* ss;
    __device__ __forceinline__ void operator()(const f32x4 (&acc)[2][2][4][2], const Unit& u, int wr, int wc, int fr, int fq) const {
        const int col0 = u.pn * BM + wc * 32 + 4 * fq;
        f32x4 gv[2][2];
#pragma unroll
        for (int bj = 0; bj < 2; ++bj)
#pragma unroll
            for (int n = 0; n < 2; ++n) gv[bj][n] = *(const f32x4*)(gain + col0 + bj * HALF + n * 16);
#pragma unroll
        for (int ai = 0; ai < 2; ++ai)
#pragma unroll
            for (int m = 0; m < 4; ++m) { const int row = u.pm * BM + ai * HALF + wr * 64 + m * 16 + fr; const size_t off = (size_t)row * 1024 + col0; float sq = 0.f;
#pragma unroll
                for (int bj = 0; bj < 2; ++bj)
#pragma unroll
                    for (int n = 0; n < 2; ++n) { const f32x4 hv = *(const f32x4*)(x + off + bj * HALF + n * 16) + acc[ai][bj][m][n];
                        sq += (hv[0] * hv[0] + hv[1] * hv[1]) + (hv[2] * hv[2] + hv[3] * hv[3]);
                        const f32x4 t = hv * gv[bj][n]; u32x2 w; w.x = cvt_pk_bf16(t[0], t[1]); w.y = cvt_pk_bf16(t[2], t[3]); *(u32x2*)(hg + off + bj * HALF + n * 16) = w; }
                sq += __shfl_xor(sq, 16); sq += __shfl_xor(sq, 32);
                if (fq == 0) atomicAdd(ss + row, sq); }
    }
};
struct EpiResid2F8 {
    static constexpr bool PERM = false, AFTER_DRAIN = false;
    const float* x; float* h; bf16_t* hg; const float* gain; float* ss;
    __device__ __forceinline__ void operator()(const f32x4 (&acc)[2][2][4][2], const Unit& u, int wr, int wc, int fr, int fq) const {
        const int col0 = u.pn * BM + wc * 32 + 4 * fq;
        f32x4 gv[2][2];
#pragma unroll
        for (int bj = 0; bj < 2; ++bj)
#pragma unroll
            for (int n = 0; n < 2; ++n) gv[bj][n] = *(const f32x4*)(gain + col0 + bj * HALF + n * 16);
#pragma unroll
        for (int ai = 0; ai < 2; ++ai)
#pragma unroll
            for (int m = 0; m < 4; ++m) { const int row = u.pm * BM + ai * HALF + wr * 64 + m * 16 + fr; const size_t off = (size_t)row * 1024 + col0; float sq = 0.f;
#pragma unroll
                for (int bj = 0; bj < 2; ++bj)
#pragma unroll
                    for (int n = 0; n < 2; ++n) { const f32x4 hv = *(const f32x4*)(x + off + bj * HALF + n * 16) + acc[ai][bj][m][n] * (1.0f / 8192.0f);
                        sq += (hv[0] * hv[0] + hv[1] * hv[1]) + (hv[2] * hv[2] + hv[3] * hv[3]);
                        const f32x4 t = hv * gv[bj][n]; u32x2 w; w.x = cvt_pk_bf16(t[0], t[1]); w.y = cvt_pk_bf16(t[2], t[3]); *(u32x2*)(hg + off + bj * HALF + n * 16) = w; }
                sq += __shfl_xor(sq, 16); sq += __shfl_xor(sq, 32);
                if (fq == 0) atomicAdd(ss + row, sq); }
    }
};
struct EpiRowScale {
    static constexpr bool PERM = true, AFTER_DRAIN = false;
    bf16_t* O; int ldc; const float* ss;
    __device__ __forceinline__ void operator()(const f32x4 (&acc)[2][2][4][2], const Unit& u, int wr, int wc, int fr, int fq) const {
        const int row0 = u.pm * BM + wr * 64 + fr, col0 = u.pn * BM + wc * 32 + 8 * fq;
#pragma unroll
        for (int ai = 0; ai < 2; ++ai)
#pragma unroll
            for (int m = 0; m < 4; ++m) { const int row = row0 + ai * HALF + m * 16; bf16_t* rowp = O + (size_t)row * ldc + col0;
                const float rs = 1.0f / sqrtf(ss[row] * (1.0f / 1024.0f) + 1e-6f);
#pragma unroll
                for (int bj = 0; bj < 2; ++bj) { const f32x4 v0 = acc[ai][bj][m][0] * rs, v1 = acc[ai][bj][m][1] * rs;
                    u32x4 w; w.x = cvt_pk_bf16(v0[0], v0[1]); w.y = cvt_pk_bf16(v0[2], v0[3]); w.z = cvt_pk_bf16(v1[0], v1[1]); w.w = cvt_pk_bf16(v1[2], v1[3]);
                    *(u32x4*)(rowp + bj * HALF) = w; } }
    }
};
}
namespace pg8 {
struct Gemm2 { const bf16_t* A0; const bf16_t* B0t; int K0; const bf16_t* A1; const bf16_t* B1t; int K1; int ld; int M, N; };
struct EpiMerge2 {
    const unsigned char* GA; const unsigned char* GR; unsigned char* O; float osc;
    static __device__ __forceinline__ f32x4 dec8(unsigned w) { const f32x2 lo = __builtin_amdgcn_cvt_pk_f32_fp8((int)w, false), hi = __builtin_amdgcn_cvt_pk_f32_fp8((int)w, true); return (f32x4){lo[0], lo[1], hi[0], hi[1]}; }
    __device__ __forceinline__ void mid(f32x4 (&acc)[2][2][4][2], const Unit& u, int wr, int wc, int fr, int fq) const {
        int row0 = u.pm * BM + wr * 64 + fr, col0 = u.pn * BM + wc * 32 + 8 * fq; asm volatile("" : "+v"(row0), "+v"(col0));
        u32x2 ga[2], gr[2], na[2], nr[2];
        { const size_t ro = (size_t)row0 * 1024 + col0; ga[0] = *(const u32x2*)(GA + ro); ga[1] = *(const u32x2*)(GA + ro + HALF); gr[0] = *(const u32x2*)(GR + ro); gr[1] = *(const u32x2*)(GR + ro + HALF); }
#pragma unroll
        for (int ai = 0; ai < 2; ++ai)
#pragma unroll
            for (int m = 0; m < 4; ++m) {
                if (ai * 4 + m < 7) { const int ai2 = (ai * 4 + m + 1) >> 2, m2 = (ai * 4 + m + 1) & 3; const size_t ro = (size_t)(row0 + ai2 * HALF + m2 * 16) * 1024 + col0;
                    na[0] = *(const u32x2*)(GA + ro); na[1] = *(const u32x2*)(GA + ro + HALF); nr[0] = *(const u32x2*)(GR + ro); nr[1] = *(const u32x2*)(GR + ro + HALF); }
#pragma unroll
                for (int bj = 0; bj < 2; ++bj) {
#pragma unroll
                    for (int n = 0; n < 2; ++n) {
                        const f32x4 r4 = dec8(gr[bj][n]), a4 = dec8(ga[bj][n]);
                        const f32x4 num = (f32x4){__expf(-r4[0]), __expf(-r4[1]), __expf(-r4[2]), __expf(-r4[3])} + 1.0f;
                        const f32x4 den = (f32x4){__expf(-a4[0]), __expf(-a4[1]), __expf(-a4[2]), __expf(-a4[3])} + 1.0f;
                        acc[ai][bj][m][n] = acc[ai][bj][m][n] * (num * (f32x4){__builtin_amdgcn_rcpf(den[0]), __builtin_amdgcn_rcpf(den[1]), __builtin_amdgcn_rcpf(den[2]), __builtin_amdgcn_rcpf(den[3])});
                        asm volatile("" : "+v"(acc[ai][bj][m][n])); } }
                asm volatile("" ::: "memory");
                ga[0] = na[0]; ga[1] = na[1]; gr[0] = nr[0]; gr[1] = nr[1]; }
    }
    __device__ __forceinline__ void fin(const f32x4 (&acc)[2][2][4][2], const Unit& u, int wr, int wc, int fr, int fq) const {
        int row0 = u.pm * BM + wr * 64 + fr, col0 = u.pn * BM + wc * 32 + 8 * fq; asm volatile("" : "+v"(row0), "+v"(col0));
#pragma unroll
        for (int ai = 0; ai < 2; ++ai)
#pragma unroll
            for (int m = 0; m < 4; ++m) { const size_t ro = (size_t)(row0 + ai * HALF + m * 16) * 1024 + col0;
#pragma unroll
                for (int bj = 0; bj < 2; ++bj) { const f32x4 v0 = acc[ai][bj][m][0], v1 = acc[ai][bj][m][1];
                    const u32x2 g = *(const u32x2*)(GR + ro + bj * HALF);
                    const f32x4 g0 = dec8(g.x), g1 = dec8(g.y);
                    int q0 = __builtin_amdgcn_cvt_pk_fp8_f32(sigm(g0[0]) * v0[0] * osc, sigm(g0[1]) * v0[1] * osc, 0, false); q0 = __builtin_amdgcn_cvt_pk_fp8_f32(sigm(g0[2]) * v0[2] * osc, sigm(g0[3]) * v0[3] * osc, q0, true);
                    int q1 = __builtin_amdgcn_cvt_pk_fp8_f32(sigm(g1[0]) * v1[0] * osc, sigm(g1[1]) * v1[1] * osc, 0, false); q1 = __builtin_amdgcn_cvt_pk_fp8_f32(sigm(g1[2]) * v1[2] * osc, sigm(g1[3]) * v1[3] * osc, q1, true);
                    *(u32x2*)(O + ro + bj * HALF) = (u32x2){(unsigned)q0, (unsigned)q1}; }
                asm volatile("" ::: "memory"); }
    }
};
template <class Epi>
__device__ __forceinline__ void gemm_phase2(PG8_LAS unsigned char* lds, const Gemm2 g, const StaticOrder& S, const Epi& E) {
    const int tid = threadIdx.x, wid = __builtin_amdgcn_readfirstlane(tid >> 6), lane = tid & 63, wr = wid >> 2, wc = wid & 3, fr = lane & 15, fq = lane >> 4;
    unsigned voffA[2], voffB[2];
#pragma unroll
    for (int i = 0; i < 2; ++i) { int R, C; stage_rc(tid * 16 + i * 8192, R, C); const int Rb = (R & ~31) + perm32(R & 31);
        voffA[i] = (unsigned)(R * g.ld + C) * 2u; voffB[i] = (unsigned)(Rb * g.ld + C) * 2u; }
    const size_t kstep = (size_t)(BK * 2);
    const size_t hstep = (size_t)HALF * g.ld * 2, tstep = 2 * hstep;
    const int nt0 = g.K0 / BK, nt1 = g.K1 / BK;
    const unsigned ldsw = (unsigned)wid * 1024u;
    const int aoff = lds_byte(wr * 64 + fr, fq * 8), boff = lds_byte(wc * 32 + fr, fq * 8);
#define PG8_SA(b, h) (((b) * 2 + (h)) * HTB)
#define PG8_SB(b, h) ((4 + (b) * 2 + (h)) * HTB)
#define PG8_STAGE(bufoff, gbase, voff) do { _Pragma("unroll") for (int _i = 0; _i < 2; ++_i) \
        __builtin_amdgcn_global_load_lds((const unsigned*)((const char*)(gbase) + (voff)[_i]), (PG8_LAS unsigned*)(lds + (bufoff) + ldsw + _i * 8192), 16, 0, 0); } while (0)
#define PG8_LDA(dst, b, h) do { _Pragma("unroll") for (int m = 0; m < 4; ++m) _Pragma("unroll") for (int k = 0; k < 2; ++k) dst[m][k] = *(const PG8_LAS bf16x8*)(lds + PG8_SA(b, h) + aoff + m * 2048 + k * 1024); } while (0)
#define PG8_LDB(dst, b, h) do { _Pragma("unroll") for (int n = 0; n < 2; ++n) _Pragma("unroll") for (int k = 0; k < 2; ++k) dst[n][k] = *(const PG8_LAS bf16x8*)(lds + PG8_SB(b, h) + boff + n * 2048 + k * 1024); } while (0)
#define PG8_MMA(ai, bj, At, Bt) do { __builtin_amdgcn_s_setprio(1); _Pragma("unroll") for (int m = 0; m < 4; ++m) _Pragma("unroll") for (int n = 0; n < 2; ++n) _Pragma("unroll") for (int k = 0; k < 2; ++k) \
        acc[ai][bj][m][n] = __builtin_amdgcn_mfma_f32_16x16x32_bf16(Bt[n][k], At[m][k], acc[ai][bj][m][n], 0, 0, 0); __builtin_amdgcn_s_setprio(0); } while (0)
#define PG8_WAIT_V(n) asm volatile("s_waitcnt vmcnt(" #n ")" ::: "memory")
#define PG8_WAIT_L(n) asm volatile("s_waitcnt lgkmcnt(" #n ")" ::: "memory")
#define PG8_BAR __builtin_amdgcn_s_barrier()
#define PG8_SCHED __builtin_amdgcn_sched_barrier(0)
    Unit cur, nxt;
    if (!S.next(0, cur)) return;
    f32x4 acc[2][2][4][2];
#pragma unroll
    for (int a = 0; a < 2; ++a)
#pragma unroll
        for (int b = 0; b < 2; ++b)
#pragma unroll
            for (int m = 0; m < 4; ++m)
#pragma unroll
                for (int n = 0; n < 2; ++n) acc[a][b][m][n] = (f32x4){0.f, 0.f, 0.f, 0.f};
    bf16x8 At[4][2], B0[2][2], B1[2][2];
    const char* cA = (const char*)g.A0 + (size_t)cur.pm * tstep; const char* cB = (const char*)g.B0t + (size_t)cur.pn * tstep;
    PG8_STAGE(PG8_SB(0, 0), cB, voffB); PG8_STAGE(PG8_SB(0, 1), cB + hstep, voffB); PG8_STAGE(PG8_SA(0, 0), cA, voffA); PG8_STAGE(PG8_SA(0, 1), cA + hstep, voffA);
    if (wr == 1) PG8_BAR;
    PG8_WAIT_V(2); PG8_BAR;
    PG8_STAGE(PG8_SB(1, 0), cB + kstep, voffB); PG8_STAGE(PG8_SA(1, 0), cA + kstep, voffA); PG8_STAGE(PG8_SB(1, 1), cB + hstep + kstep, voffB);
    PG8_WAIT_V(6); PG8_BAR;
#define PG8_KLOOP(NT) do { for (int t = 0; t < (NT); t += 2) { \
            const bool last = (t == (NT) - 2); \
            const char* a1 = cA + (size_t)(t + 1) * kstep; \
            const char* a2 = last ? nA : cA + (size_t)(t + 2) * kstep; const char* b2 = last ? nB : cB + (size_t)(t + 2) * kstep; \
            const char* a3 = a2 + kstep; const char* b3 = b2 + kstep; \
            PG8_LDB(B0, 0, 0); PG8_LDB(B1, 0, 1); PG8_SCHED; PG8_LDA(At, 0, 0); PG8_STAGE(PG8_SA(1, 1), a1 + hstep, voffA); \
            PG8_WAIT_V(8); PG8_WAIT_L(0); PG8_BAR; PG8_MMA(0, 0, At, B0); PG8_MMA(0, 1, At, B1); PG8_BAR; PG8_SCHED; \
            PG8_LDA(At, 0, 1); PG8_STAGE(PG8_SB(0, 0), b2, voffB); PG8_STAGE(PG8_SB(0, 1), b2 + hstep, voffB); PG8_STAGE(PG8_SA(0, 0), a2, voffA); \
            PG8_WAIT_V(8); PG8_WAIT_L(0); PG8_BAR; PG8_MMA(1, 0, At, B0); PG8_MMA(1, 1, At, B1); PG8_BAR; PG8_SCHED; \
            PG8_LDB(B0, 1, 0); PG8_LDB(B1, 1, 1); PG8_SCHED; PG8_LDA(At, 1, 0); PG8_STAGE(PG8_SA(0, 1), a2 + hstep, voffA); \
            PG8_WAIT_V(8); PG8_WAIT_L(0); PG8_BAR; PG8_MMA(0, 0, At, B0); PG8_MMA(0, 1, At, B1); PG8_BAR; PG8_SCHED; \
            PG8_LDA(At, 1, 1); PG8_STAGE(PG8_SB(1, 0), b3, voffB); PG8_STAGE(PG8_SB(1, 1), b3 + hstep, voffB); PG8_STAGE(PG8_SA(1, 0), a3, voffA); \
            PG8_WAIT_V(8); PG8_WAIT_L(0); PG8_BAR; PG8_MMA(1, 0, At, B0); PG8_MMA(1, 1, At, B1); PG8_BAR; PG8_SCHED; } } while (0)
    int ti = 0;
    for (;;) {
        const char* nA = (const char*)g.A1 + (size_t)cur.pm * tstep; const char* nB = (const char*)g.B1t + (size_t)cur.pn * tstep;
        PG8_KLOOP(nt0);
        if (wr == 0) PG8_BAR;
        PG8_SCHED; E.mid(acc, cur, wr, wc, fr, fq); PG8_SCHED;
        cA = nA; cB = nB;
        if (wr == 1) PG8_BAR;
        const bool has_next = S.next(ti + 1, nxt);
        nA = has_next ? (const char*)g.A0 + (size_t)nxt.pm * tstep : cA; nB = has_next ? (const char*)g.B0t + (size_t)nxt.pn * tstep : cB;
        PG8_KLOOP(nt1);
        if (wr == 0) PG8_BAR;
        PG8_SCHED; E.fin(acc, cur, wr, wc, fr, fq); PG8_SCHED;
        if (!has_next) break;
#pragma unroll
        for (int a = 0; a < 2; ++a)
#pragma unroll
            for (int b = 0; b < 2; ++b)
#pragma unroll
                for (int m = 0; m < 4; ++m)
#pragma unroll
                    for (int n = 0; n < 2; ++n) acc[a][b][m][n] = (f32x4){0.f, 0.f, 0.f, 0.f};
        cur = nxt; cA = nA; cB = nB; ++ti;
        if (wr == 1) PG8_BAR;
    }
#undef PG8_KLOOP
    PG8_WAIT_V(0);
    PG8_BAR;
#undef PG8_SA
#undef PG8_SB
#undef PG8_STAGE
#undef PG8_LDA
#undef PG8_LDB
#undef PG8_MMA
#undef PG8_WAIT_V
#undef PG8_WAIT_L
#undef PG8_BAR
#undef PG8_SCHED
}
struct Gemm2F8 { const unsigned char* A0; const unsigned char* B0t; int K0; const unsigned char* A1; const unsigned char* B1t; int K1; int ld; int M, N; };
template <class Epi>
__device__ __forceinline__ void gemm_phase2_f8(PG8_LAS unsigned char* lds, const Gemm2F8 g, const StaticOrder& S, const Epi& E) {
    const int tid = threadIdx.x, wid = __builtin_amdgcn_readfirstlane(tid >> 6), lane = tid & 63, wr = wid >> 2, wc = wid & 3, fr = lane & 15, fq = lane >> 4;
    unsigned voffA[2], voffB[2];
#pragma unroll
    for (int i = 0; i < 2; ++i) { int R, C; stage_rc(tid * 16 + i * 8192, R, C); const int Rb = (R & ~31) + perm32(R & 31);
        voffA[i] = (unsigned)(R * g.ld + C * 2); voffB[i] = (unsigned)(Rb * g.ld + C * 2); }
    const size_t kstep = (size_t)(BK * 2);
    const size_t hstep = (size_t)HALF * g.ld, tstep = 2 * hstep;
    int k0_ = g.K0, k1_ = g.K1; asm volatile("" : "+s"(k0_), "+s"(k1_));
    const int nt0 = k0_ / 128, nt1 = k1_ / 128;
    const unsigned ldsw = (unsigned)wid * 1024u;
    const int aoff = lds_byte(wr * 64 + fr, fq * 8), boff = lds_byte(wc * 32 + fr, fq * 8);
#define PG8_SA(b, h) (((b) * 2 + (h)) * HTB)
#define PG8_SB(b, h) ((4 + (b) * 2 + (h)) * HTB)
#define PG8_STAGE(bufoff, gbase, voff) do { _Pragma("unroll") for (int _i = 0; _i < 2; ++_i) \
        __builtin_amdgcn_global_load_lds((const unsigned*)((const char*)(gbase) + (voff)[_i]), (PG8_LAS unsigned*)(lds + (bufoff) + ldsw + _i * 8192), 16, 0, 0); } while (0)
#define PG8_LDA(dst, b, h) do { _Pragma("unroll") for (int m = 0; m < 4; ++m) { const i32x4 lo_ = *(const PG8_LAS i32x4*)(lds + PG8_SA(b, h) + aoff + m * 2048), hi_ = *(const PG8_LAS i32x4*)(lds + PG8_SA(b, h) + aoff + m * 2048 + 1024); dst[m] = __builtin_shufflevector(lo_, hi_, 0, 1, 2, 3, 4, 5, 6, 7); } } while (0)
#define PG8_LDB(dst, b, h) do { _Pragma("unroll") for (int n = 0; n < 2; ++n) { const i32x4 lo_ = *(const PG8_LAS i32x4*)(lds + PG8_SB(b, h) + boff + n * 2048), hi_ = *(const PG8_LAS i32x4*)(lds + PG8_SB(b, h) + boff + n * 2048 + 1024); dst[n] = __builtin_shufflevector(lo_, hi_, 0, 1, 2, 3, 4, 5, 6, 7); } } while (0)
#define PG8_MMA(ai, bj, At, Bt) do { __builtin_amdgcn_s_setprio(1); _Pragma("unroll") for (int m = 0; m < 4; ++m) _Pragma("unroll") for (int n = 0; n < 2; ++n) \
        asm volatile("v_mfma_f32_16x16x128_f8f6f4 %0, %1, %2, %0" : "+v"(acc[ai][bj][m][n]) : "v"(Bt[n]), "v"(At[m])); __builtin_amdgcn_s_setprio(0); } while (0)
#define PG8_GUARD do { asm volatile("s_nop 15\n\ts_nop 15" ::: "memory"); _Pragma("unroll") for (int a_ = 0; a_ < 2; ++a_) _Pragma("unroll") for (int b_ = 0; b_ < 2; ++b_) \
        asm volatile("" : "+v"(acc[a_][b_][0][0]), "+v"(acc[a_][b_][0][1]), "+v"(acc[a_][b_][1][0]), "+v"(acc[a_][b_][1][1]), "+v"(acc[a_][b_][2][0]), "+v"(acc[a_][b_][2][1]), "+v"(acc[a_][b_][3][0]), "+v"(acc[a_][b_][3][1])); } while (0)
#define PG8_WAIT_V(n) asm volatile("s_waitcnt vmcnt(" #n ")" ::: "memory")
#define PG8_WAIT_L(n) asm volatile("s_waitcnt lgkmcnt(" #n ")" ::: "memory")
#define PG8_BAR __builtin_amdgcn_s_barrier()
#define PG8_SCHED __builtin_amdgcn_sched_barrier(0)
    Unit cur, nxt;
    if (!S.next(0, cur)) return;
    f32x4 acc[2][2][4][2];
#pragma unroll
    for (int a = 0; a < 2; ++a)
#pragma unroll
        for (int b = 0; b < 2; ++b)
#pragma unroll
            for (int m = 0; m < 4; ++m)
#pragma unroll
                for (int n = 0; n < 2; ++n) acc[a][b][m][n] = (f32x4){0.f, 0.f, 0.f, 0.f};
    i32x8 At[4], B0[2], B1[2];
    const char* cA = (const char*)g.A0 + (size_t)cur.pm * tstep; const char* cB = (const char*)g.B0t + (size_t)cur.pn * tstep;
    unsigned tch[3];
    { const int q = cur.pn & 3, id = q * 512 + tid;
      const int l1 = g.K1 >> 7, l0 = g.K0 >> 7;
      const char* p1 = (const char*)g.A1 + (size_t)cur.pm * tstep; const char* p0 = (const char*)g.A0 + (size_t)cur.pm * tstep;
      { const int ln = id; const int r = ln / l1, c = ln % l1; tch[0] = r < 256 ? *(const unsigned*)(p1 + (size_t)r * g.ld + c * 128) : 0u; }
      { const int ln = id + 2048; const int r = ln / l1, c = ln % l1; tch[1] = r < 256 ? *(const unsigned*)(p1 + (size_t)r * g.ld + c * 128) : 0u; }
      { const int ln = id; const int r = ln / l0, c = ln % l0; tch[2] = r < 256 ? *(const unsigned*)(p0 + (size_t)r * g.ld + c * 128) : 0u; } }
    PG8_STAGE(PG8_SB(0, 0), cB, voffB); PG8_STAGE(PG8_SB(0, 1), cB + hstep, voffB); PG8_STAGE(PG8_SA(0, 0), cA, voffA); PG8_STAGE(PG8_SA(0, 1), cA + hstep, voffA);
    if (wr == 1) PG8_BAR;
    PG8_WAIT_V(2); PG8_BAR;
    PG8_STAGE(PG8_SB(1, 0), cB + kstep, voffB); PG8_STAGE(PG8_SA(1, 0), cA + kstep, voffA); PG8_STAGE(PG8_SB(1, 1), cB + hstep + kstep, voffB);
    PG8_WAIT_V(6); PG8_BAR;
    asm volatile("" :: "v"(tch[0]), "v"(tch[1]), "v"(tch[2]));
#define PG8_KLOOP(NT) do { _Pragma("unroll 1") for (int t = 0; t < (NT); t += 2) { \
            const bool last = (t == (NT) - 2); \
            const char* a1 = cA + (size_t)(t + 1) * kstep; \
            const char* a2 = last ? nA : cA + (size_t)(t + 2) * kstep; const char* b2 = last ? nB : cB + (size_t)(t + 2) * kstep; \
            const char* a3 = a2 + kstep; const char* b3 = b2 + kstep; \
            PG8_LDB(B0, 0, 0); PG8_LDB(B1, 0, 1); PG8_SCHED; PG8_LDA(At, 0, 0); PG8_STAGE(PG8_SA(1, 1), a1 + hstep, voffA); \
            PG8_WAIT_V(8); PG8_WAIT_L(0); PG8_BAR; PG8_MMA(0, 0, At, B0); PG8_MMA(0, 1, At, B1); PG8_BAR; PG8_SCHED; \
            PG8_LDA(At, 0, 1); PG8_STAGE(PG8_SB(0, 0), b2, voffB); PG8_STAGE(PG8_SB(0, 1), b2 + hstep, voffB); PG8_STAGE(PG8_SA(0, 0), a2, voffA); \
            PG8_WAIT_V(8); PG8_WAIT_L(0); PG8_BAR; PG8_MMA(1, 0, At, B0); PG8_MMA(1, 1, At, B1); PG8_BAR; PG8_SCHED; \
            PG8_LDB(B0, 1, 0); PG8_LDB(B1, 1, 1); PG8_SCHED; PG8_LDA(At, 1, 0); PG8_STAGE(PG8_SA(0, 1), a2 + hstep, voffA); \
            PG8_WAIT_V(8); PG8_WAIT_L(0); PG8_BAR; PG8_MMA(0, 0, At, B0); PG8_MMA(0, 1, At, B1); PG8_BAR; PG8_SCHED; \
            PG8_LDA(At, 1, 1); PG8_STAGE(PG8_SB(1, 0), b3, voffB); PG8_STAGE(PG8_SB(1, 1), b3 + hstep, voffB); PG8_STAGE(PG8_SA(1, 0), a3, voffA); \
            PG8_WAIT_V(8); PG8_WAIT_L(0); PG8_BAR; PG8_MMA(1, 0, At, B0); PG8_MMA(1, 1, At, B1); PG8_BAR; PG8_SCHED; } } while (0)
    int ti = 0;
    for (;;) {
        const char* nA = (const char*)g.A1 + (size_t)cur.pm * tstep; const char* nB = (const char*)g.B1t + (size_t)cur.pn * tstep;
        PG8_KLOOP(nt0);
        if (wr == 0) PG8_BAR;
        PG8_GUARD; PG8_SCHED; E.mid(acc, cur, wr, wc, fr, fq); PG8_SCHED;
        cA = nA; cB = nB;
        if (wr == 1) PG8_BAR;
        const bool has_next = S.next(ti + 1, nxt);
        nA = has_next ? (const char*)g.A0 + (size_t)nxt.pm * tstep : cA; nB = has_next ? (const char*)g.B0t + (size_t)nxt.pn * tstep : cB;
        PG8_KLOOP(nt1);
        if (wr == 0) PG8_BAR;
        PG8_GUARD; PG8_SCHED; E.fin(acc, cur, wr, wc, fr, fq); PG8_SCHED;
        if (!has_next) break;
#pragma unroll
        for (int a = 0; a < 2; ++a)
#pragma unroll
            for (int b = 0; b < 2; ++b)
#pragma unroll
                for (int m = 0; m < 4; ++m)
#pragma unroll
                    for (int n = 0; n < 2; ++n) acc[a][b][m][n] = (f32x4){0.f, 0.f, 0.f, 0.f};
        cur = nxt; cA = nA; cB = nB; ++ti;
        if (wr == 1) PG8_BAR;
    }
#undef PG8_KLOOP
    PG8_WAIT_V(0);
    PG8_BAR;
#undef PG8_SA
#undef PG8_SB
#undef PG8_STAGE
#undef PG8_LDA
#undef PG8_LDB
#undef PG8_MMA
#undef PG8_WAIT_V
#undef PG8_WAIT_L
#undef PG8_BAR
#undef PG8_SCHED
#undef PG8_GUARD
}
}

#define GAS __attribute__((address_space(1)))
#define LAS __attribute__((address_space(3)))
typedef unsigned short bf16;
typedef unsigned v4u __attribute__((ext_vector_type(4)));
typedef float f32x4 __attribute__((ext_vector_type(4)));
typedef short bf16x8 __attribute__((ext_vector_type(8)));
typedef GAS unsigned gu32;
typedef GAS unsigned long long gu64;
#define RLX_AGENT __ATOMIC_RELAXED, __HIP_MEMORY_SCOPE_AGENT
#define LDS_WAIT() asm volatile("s_waitcnt lgkmcnt(0)" ::: "memory")
#define VM_WAIT() asm volatile("s_waitcnt vmcnt(0)" ::: "memory")
__device__ __forceinline__ unsigned long long rt() { return __builtin_amdgcn_s_memrealtime(); }
__device__ __forceinline__ unsigned f2bf(float f) { unsigned u = __builtin_bit_cast(unsigned, f); return (u + 0x7fffu + ((u >> 16) & 1u)) >> 16; }
__device__ __forceinline__ unsigned pk2(float lo, float hi) { return f2bf(lo) | (f2bf(hi) << 16); }
#define XB_TMO      128
#define XB_XCNT(j)  (256  + 64 * (j))
#define XB_XSUB(j)  (1280 + 64 * (j))
#define XB_XGEN(j)  (2304 + 64 * (j))
#define XB_TOP      3328
#define XB_TOPGEN   3392
#define XCD_BAR_WORDS 3456
#define XB_SPIN_CAP (1u << 18)

__device__ __forceinline__ unsigned xb_ld(unsigned* p)              { return __hip_atomic_load(p, __ATOMIC_RELAXED, __HIP_MEMORY_SCOPE_AGENT); }
__device__ __forceinline__ unsigned xb_add(unsigned* p, unsigned v) { return __hip_atomic_fetch_add(p, v, __ATOMIC_RELAXED, __HIP_MEMORY_SCOPE_AGENT); }
__device__ __forceinline__ unsigned xb_xcc_id() { return (unsigned)__builtin_amdgcn_s_getreg((3 << 11) | 20) & 0xFu; }
#define XB_SPIN(cond, bar) do { unsigned _sp = 0; while (cond) { __builtin_amdgcn_s_sleep(1); \
    if ((++_sp & 255u) == 0u) { if (xb_ld(&(bar)[XB_TMO])) break; if (_sp > XB_SPIN_CAP) { atomicAdd(&(bar)[XB_TMO], 1u); break; } } } } while (0)

struct XcdBarrier {
    unsigned* bar; unsigned x;
    volatile LAS unsigned* st;
};

__device__ __forceinline__ XcdBarrier xcd_barrier_post(unsigned* bar, volatile LAS unsigned* st) {
    XcdBarrier b; b.bar = bar; b.x = xb_xcc_id(); b.st = st;
    if (threadIdx.x == 0) (void)xb_add(&bar[XB_XCNT(b.x)], 1u);
    return b;
}
__device__ __forceinline__ void xcd_barrier_complete(unsigned* bar, unsigned x, unsigned& nloc, unsigned& nx) {
    const unsigned G = gridDim.x * gridDim.y * gridDim.z;
    unsigned sum, cnt, mine, sp = 0u;
    for (;;) {
        sum = 0u; cnt = 0u; mine = 0u;
#pragma unroll
        for (unsigned j = 0; j < 16; ++j) { const unsigned c = xb_ld(&bar[XB_XCNT(j)]); sum += c; cnt += (c > 0u) ? 1u : 0u; mine = (j == x) ? c : mine; }
        if (sum == G) break;
        __builtin_amdgcn_s_sleep(1);
        if ((++sp & 255u) == 0u) { if (xb_ld(&bar[XB_TMO])) break; if (sp > XB_SPIN_CAP) { atomicAdd(&bar[XB_TMO], 1u); break; } }
    }
    nloc = mine > 0u ? mine : 1u; nx = cnt > 0u ? cnt : 1u;
}

__device__ __forceinline__ void xcd_barrier(const XcdBarrier& b) {
    asm volatile("s_waitcnt vmcnt(0)" ::: "memory");
    __syncthreads();
    if (threadIdx.x == 0) {
        unsigned* bar = b.bar;
        __builtin_amdgcn_s_waitcnt(0);
        unsigned nloc = b.st[0], nx = b.st[1];
        if (nloc == 0u) { xcd_barrier_complete(bar, b.x, nloc, nx); b.st[0] = nloc; b.st[1] = nx; }
        const unsigned old = xb_add(&bar[XB_XSUB(b.x)], 1u);
        const unsigned gen = old / nloc;
        if (old + 1u == (gen + 1u) * nloc) {
            __builtin_amdgcn_fence(__ATOMIC_RELEASE, "agent");
            asm volatile("s_waitcnt vmcnt(0)" ::: "memory");
            const unsigned og = xb_add(&bar[XB_TOP], 1u);
            const unsigned tg = og / nx;
            if (og + 1u == (tg + 1u) * nx) xb_add(&bar[XB_TOPGEN], 1u);
            else XB_SPIN(xb_ld(&bar[XB_TOPGEN]) == tg, bar);
            __builtin_amdgcn_fence(__ATOMIC_ACQUIRE, "agent");
            xb_add(&bar[XB_XGEN(b.x)], 1u);
            asm volatile("s_waitcnt vmcnt(0)" ::: "memory");
        } else {
            XB_SPIN(xb_ld(&bar[XB_XGEN(b.x)]) == gen, bar);
            __builtin_amdgcn_fence(__ATOMIC_ACQUIRE, "agent");
            asm volatile("s_waitcnt vmcnt(0)" ::: "memory");
        }
    }
    __syncthreads();
}
constexpr int NWAVES = 8, NTHR = 512;
constexpr int RING_OFF = 0, RING_BYTES = 131072;
constexpr int LDSCTL_OFF = RING_BYTES, MISC_OFF = LDSCTL_OFF + 320;
constexpr int LDS_BYTES = 147456;
struct Args { const float* in[14]; float* out; unsigned char* ws; int ph_lo, ph_hi; };

typedef unsigned v2u __attribute__((ext_vector_type(2)));
__device__ __forceinline__ float bfl(unsigned w) { return __builtin_bit_cast(float, w << 16); }
__device__ __forceinline__ float bfh(unsigned w) { return __builtin_bit_cast(float, w & 0xffff0000u); }
__device__ __forceinline__ float bf2f(unsigned h) { return __builtin_bit_cast(float, h << 16); }
__device__ __forceinline__ float wave_sum(float v) {
#pragma unroll
    for (int o = 1; o < 64; o <<= 1) v += __shfl_xor(v, o);
    return v;
}

__device__ __forceinline__ void p0_transpose_item(const float* W, int K, int N, bf16* WT, LAS float* scr, int item, int lane, int pitch = 0, unsigned char* WT8 = nullptr) {
    if (pitch == 0) pitch = K;
    const int nblk = N / 32, kb = item / nblk, nb = item % nblk, k0 = 64 * kb, n0 = 32 * nb;
#pragma unroll 8
    for (int i = 0; i < 32; ++i) { const int kk = 2 * i + (lane >> 5); scr[kk * 33 + (lane & 31)] = W[(size_t)(k0 + kk) * N + n0 + (lane & 31)]; }
    LDS_WAIT(); asm volatile("" ::: "memory");
    const int c = lane & 7;
    if (WT8) {
#pragma unroll
        for (int j = 0; j < 4; ++j) { const int n = (lane >> 3) + 8 * j; const LAS float* s = scr + (8 * c) * 33 + n;
            int q0 = __builtin_amdgcn_cvt_pk_fp8_f32(s[0 * 33] * 512.f, s[1 * 33] * 512.f, 0, false); q0 = __builtin_amdgcn_cvt_pk_fp8_f32(s[2 * 33] * 512.f, s[3 * 33] * 512.f, q0, true);
            int q1 = __builtin_amdgcn_cvt_pk_fp8_f32(s[4 * 33] * 512.f, s[5 * 33] * 512.f, 0, false); q1 = __builtin_amdgcn_cvt_pk_fp8_f32(s[6 * 33] * 512.f, s[7 * 33] * 512.f, q1, true);
            *(GAS v2u*)(WT8 + (size_t)(n0 + n) * pitch + k0 + 8 * c) = (v2u){(unsigned)q0, (unsigned)q1}; }
        LDS_WAIT(); asm volatile("" ::: "memory");
        return;
    }
#pragma unroll
    for (int j = 0; j < 4; ++j) { const int n = (lane >> 3) + 8 * j; const LAS float* s = scr + (8 * c) * 33 + n;
        v4u o; o.x = pk2(s[0 * 33], s[1 * 33]); o.y = pk2(s[2 * 33], s[3 * 33]); o.z = pk2(s[4 * 33], s[5 * 33]); o.w = pk2(s[6 * 33], s[7 * 33]);
        *(GAS v4u*)(WT + (size_t)(n0 + n) * pitch + k0 + 8 * c) = o; }
    LDS_WAIT(); asm volatile("" ::: "memory");
}

__device__ __forceinline__ void p0_win_i8(const float* W, unsigned char* W8, float* csc, LAS float* red, int wg, int nwg) {
    const int tid = threadIdx.x, c = tid & 31, r8 = tid >> 5;
    for (int blk = wg; blk * 23 < INW; blk += nwg) {
        const int n = blk * 23 + c; const bool act = c < 23;
        float w[64]; float mx = 0.f;
        if (act) {
            const GAS float* wp = (const GAS float*)W + (size_t)(64 * r8) * INW + n;
#pragma unroll
            for (int j = 0; j < 64; ++j) w[j] = wp[(size_t)j * INW];
#pragma unroll
            for (int j = 0; j < 64; ++j) mx = fmaxf(mx, fabsf(w[j]));
        }
        __syncthreads();
        red[r8 * 32 + c] = mx;
        __syncthreads();
#pragma unroll
        for (int j = 0; j < 16; ++j) mx = fmaxf(mx, red[j * 32 + c]);
        if (act) {
            const float qs = mx > 0.f ? 127.0f / mx : 0.f;
            if (r8 == 0) csc[n] = mx * (1.0f / 127.0f);
            GAS v4u* op = (GAS v4u*)(W8 + (size_t)n * DM + 64 * r8);
#pragma unroll
            for (int q = 0; q < 4; ++q) { unsigned d[4];
#pragma unroll
                for (int e = 0; e < 4; ++e) { const int b0 = (int)rintf(w[16 * q + 4 * e] * qs), b1 = (int)rintf(w[16 * q + 4 * e + 1] * qs), b2 = (int)rintf(w[16 * q + 4 * e + 2] * qs), b3 = (int)rintf(w[16 * q + 4 * e + 3] * qs);
                    d[e] = (unsigned)(b0 & 255) | ((unsigned)(b1 & 255) << 8) | ((unsigned)(b2 & 255) << 16) | ((unsigned)b3 << 24); }
                op[q] = (v4u){d[0], d[1], d[2], d[3]}; }
        }
    }
    __syncthreads();
}
__device__ __forceinline__ void rms_row_to_bf16(const float* xrow, const float* gain, bf16* orow, unsigned* o8row, float* rsc, int lane) {
    const GAS f32x4* xr = (const GAS f32x4*)xrow + lane;
    f32x4 v[4]; float s = 0.f;
#pragma unroll
    for (int j = 0; j < 4; ++j) { v[j] = xr[64 * j]; s += (v[j].x * v[j].x + v[j].y * v[j].y) + (v[j].z * v[j].z + v[j].w * v[j].w); }
    const float rstd = 1.f / sqrtf(wave_sum(s) * (1.f / DM) + EPS);
#pragma unroll
    for (int j = 0; j < 4; ++j) { const f32x4 g = ((const GAS f32x4*)gain)[lane + 64 * j];
        v[j] = (f32x4){v[j].x * rstd * g.x, v[j].y * rstd * g.y, v[j].z * rstd * g.z, v[j].w * rstd * g.w}; }
    float mx = 0.f;
#pragma unroll
    for (int j = 0; j < 4; ++j) mx = fmaxf(fmaxf(mx, fmaxf(fabsf(v[j].x), fabsf(v[j].y))), fmaxf(fabsf(v[j].z), fabsf(v[j].w)));
#pragma unroll
    for (int o = 1; o < 64; o <<= 1) mx = fmaxf(mx, __shfl_xor(mx, o));
    const float qs = mx > 0.f ? 127.0f / mx : 0.f;
#pragma unroll
    for (int j = 0; j < 4; ++j) {
        const int q0 = (int)rintf(v[j].x * qs), q1 = (int)rintf(v[j].y * qs), q2 = (int)rintf(v[j].z * qs), q3 = (int)rintf(v[j].w * qs);
        ((GAS unsigned*)o8row)[lane + 64 * j] = (unsigned)(q0 & 255) | ((unsigned)(q1 & 255) << 8) | ((unsigned)(q2 & 255) << 16) | ((unsigned)q3 << 24); }
    if (lane == 0) *rsc = mx * (1.0f / 127.0f);
}
__device__ __forceinline__ void p_tables(float* tab, int gtid, int gthreads) {
    float* cosA = tab, *sinA = tab + 2048 * 8, *cosR = tab + 2048 * 16, *sinR = tab + 2048 * 16 + 2048 * 32;
    for (int i = gtid; i < 2048 * 40; i += gthreads) {
        const int pos = i / 40, f = i % 40;
        if (f < 8) { const float inv = (float)pow(500000.0, -(double)f / 8.0); const float ang = (float)pos * inv;
            cosA[pos * 8 + f] = (float)cos((double)ang); sinA[pos * 8 + f] = (float)sin((double)ang); }
        else { const int g = f - 8; const float inv = (float)pow(10000.0, -(double)g / 32.0); const float ang = (float)pos * inv;
            cosR[pos * 32 + g] = (float)cos((double)ang); sinR[pos * 32 + g] = (float)sin((double)ang); }
    }
}

typedef __bf16 bf16x2_t __attribute__((ext_vector_type(2)));
template <int CTRL> __device__ __forceinline__ float dpp_f(float v) { return __builtin_bit_cast(float, __builtin_amdgcn_update_dpp(0, __builtin_bit_cast(int, v), CTRL, 0xf, 0xf, false)); }

typedef float f32x2_t __attribute__((ext_vector_type(2)));

__device__ __forceinline__ void row_to_fp4(const float* xrow, unsigned char* o4, float* scale_out, int lane) {
    const GAS f32x4* xr = (const GAS f32x4*)xrow + lane;
    f32x4 v[4]; float mx = 0.f;
#pragma unroll
    for (int j = 0; j < 4; ++j) { v[j] = xr[64 * j]; mx = fmaxf(fmaxf(mx, fmaxf(fabsf(v[j].x), fabsf(v[j].y))), fmaxf(fabsf(v[j].z), fabsf(v[j].w))); }
#pragma unroll
    for (int o = 1; o < 64; o <<= 1) mx = fmaxf(mx, __shfl_xor(mx, o));
    const float sc = mx > 0.f ? mx * (1.0f / 6.0f) : 1.0f, inv = 1.0f / sc;
    unsigned w0 = 0u, w1 = 0u;
    w0 = __builtin_amdgcn_cvt_scalef32_pk_fp4_f32(w0, v[0].x * inv, v[0].y * inv, 1.0f, 0); w0 = __builtin_amdgcn_cvt_scalef32_pk_fp4_f32(w0, v[0].z * inv, v[0].w * inv, 1.0f, 1);
    w0 = __builtin_amdgcn_cvt_scalef32_pk_fp4_f32(w0, v[1].x * inv, v[1].y * inv, 1.0f, 2); w0 = __builtin_amdgcn_cvt_scalef32_pk_fp4_f32(w0, v[1].z * inv, v[1].w * inv, 1.0f, 3);
    w1 = __builtin_amdgcn_cvt_scalef32_pk_fp4_f32(w1, v[2].x * inv, v[2].y * inv, 1.0f, 0); w1 = __builtin_amdgcn_cvt_scalef32_pk_fp4_f32(w1, v[2].z * inv, v[2].w * inv, 1.0f, 1);
    w1 = __builtin_amdgcn_cvt_scalef32_pk_fp4_f32(w1, v[3].x * inv, v[3].y * inv, 1.0f, 2); w1 = __builtin_amdgcn_cvt_scalef32_pk_fp4_f32(w1, v[3].z * inv, v[3].w * inv, 1.0f, 3);
    *(GAS unsigned long long*)(o4 + 8 * lane) = (unsigned long long)w0 | ((unsigned long long)w1 << 32);
    if (lane == 0) *scale_out = sc;
}
template <int NR> __device__ __forceinline__ void rows_to_fp4(const float* const (&xrow)[NR], unsigned char* const (&o4)[NR], float* const (&sco)[NR], int lane) {
    f32x4 v[NR][4];
#pragma unroll
    for (int r = 0; r < NR; ++r) { const GAS f32x4* xr = (const GAS f32x4*)xrow[r] + lane;
#pragma unroll
        for (int j = 0; j < 4; ++j) v[r][j] = xr[64 * j]; }
#pragma unroll
    for (int r = 0; r < NR; ++r) {
        float mx = 0.f;
#pragma unroll
        for (int j = 0; j < 4; ++j) mx = fmaxf(fmaxf(mx, fmaxf(fabsf(v[r][j].x), fabsf(v[r][j].y))), fmaxf(fabsf(v[r][j].z), fabsf(v[r][j].w)));
#pragma unroll
        for (int o = 1; o < 64; o <<= 1) mx = fmaxf(mx, __shfl_xor(mx, o));
        const float sc = mx > 0.f ? mx * (1.0f / 6.0f) : 1.0f, inv = 1.0f / sc;
        unsigned w0 = 0u, w1 = 0u;
        w0 = __builtin_amdgcn_cvt_scalef32_pk_fp4_f32(w0, v[r][0].x * inv, v[r][0].y * inv, 1.0f, 0); w0 = __builtin_amdgcn_cvt_scalef32_pk_fp4_f32(w0, v[r][0].z * inv, v[r][0].w * inv, 1.0f, 1);
        w0 = __builtin_amdgcn_cvt_scalef32_pk_fp4_f32(w0, v[r][1].x * inv, v[r][1].y * inv, 1.0f, 2); w0 = __builtin_amdgcn_cvt_scalef32_pk_fp4_f32(w0, v[r][1].z * inv, v[r][1].w * inv, 1.0f, 3);
        w1 = __builtin_amdgcn_cvt_scalef32_pk_fp4_f32(w1, v[r][2].x * inv, v[r][2].y * inv, 1.0f, 0); w1 = __builtin_amdgcn_cvt_scalef32_pk_fp4_f32(w1, v[r][2].z * inv, v[r][2].w * inv, 1.0f, 1);
        w1 = __builtin_amdgcn_cvt_scalef32_pk_fp4_f32(w1, v[r][3].x * inv, v[r][3].y * inv, 1.0f, 2); w1 = __builtin_amdgcn_cvt_scalef32_pk_fp4_f32(w1, v[r][3].z * inv, v[r][3].w * inv, 1.0f, 3);
        *(GAS unsigned long long*)(o4[r] + 8 * lane) = (unsigned long long)w0 | ((unsigned long long)w1 << 32);
        if (lane == 0) *sco[r] = sc;
    }
}
__device__ __forceinline__ float gelu_as(float v) {
    const float av = fabsf(v), t = __builtin_amdgcn_rcpf(av * 0.2316418882f + 1.0f);
    float q = t * 0.5307027145f + (-0.7265760135f); q = q * t + 0.7107068705f; q = q * t + (-0.142248368f); q = q * t + 0.127414796f; q = q * t;
    const float e = __builtin_amdgcn_exp2f((v * v) * (-0.72134752044f));
    const float m = v * (q * e);
    return v < 0.f ? m : v - m;
}
struct PeerTabs { const unsigned char* U4; const unsigned char* V4; const float* SU; const float* SV; };
struct PeerBuf8 { unsigned u[8][2], v[8][2]; };
__device__ __forceinline__ void peer_load8(PeerBuf8& B, const PeerTabs& Tb, int i0, int i1, int hh, int lane) {
    int e[8];
#pragma unroll
    for (int j = 0; j < 8; ++j) { const int k = hh * 8 + j; e[j] = __builtin_amdgcn_readlane(k < 64 ? i0 : i1, k & 63); }
#pragma unroll
    for (int j = 0; j < 8; ++j) { const v2u t = *(const v2u*)(Tb.U4 + (size_t)e[j] * 1024 + 8 * lane); B.u[j][0] = t.x; B.u[j][1] = t.y; }
#pragma unroll
    for (int j = 0; j < 8; ++j) { const v2u t = *(const v2u*)(Tb.U4 + (size_t)e[j] * 1024 + 512 + 8 * lane); B.v[j][0] = t.x; B.v[j][1] = t.y; }
}
__device__ __forceinline__ void dec4(const unsigned (&w)[2], float (&f)[16]) {
#pragma unroll
    for (int dw = 0; dw < 2; ++dw) {
        const f32x2_t a = __builtin_amdgcn_cvt_scalef32_pk_f32_fp4(w[dw], 1.0f, 0), b = __builtin_amdgcn_cvt_scalef32_pk_f32_fp4(w[dw], 1.0f, 1);
        const f32x2_t c = __builtin_amdgcn_cvt_scalef32_pk_f32_fp4(w[dw], 1.0f, 2), d = __builtin_amdgcn_cvt_scalef32_pk_f32_fp4(w[dw], 1.0f, 3);
        f[8 * dw] = a.x; f[8 * dw + 1] = a.y; f[8 * dw + 2] = b.x; f[8 * dw + 3] = b.y; f[8 * dw + 4] = c.x; f[8 * dw + 5] = c.y; f[8 * dw + 6] = d.x; f[8 * dw + 7] = d.y;
    }
}
__device__ __forceinline__ float quad_reduce(const float (&p)[4]) {
    float q0, q1, r;
    { auto t = __builtin_amdgcn_permlane32_swap(__builtin_bit_cast(unsigned, p[0]), __builtin_bit_cast(unsigned, p[1]), false, false); const unsigned t0 = t[0], t1 = t[1]; q0 = __builtin_bit_cast(float, t0) + __builtin_bit_cast(float, t1); }
    { auto t = __builtin_amdgcn_permlane32_swap(__builtin_bit_cast(unsigned, p[2]), __builtin_bit_cast(unsigned, p[3]), false, false); const unsigned t0 = t[0], t1 = t[1]; q1 = __builtin_bit_cast(float, t0) + __builtin_bit_cast(float, t1); }
    { auto t = __builtin_amdgcn_permlane16_swap(__builtin_bit_cast(unsigned, q0), __builtin_bit_cast(unsigned, q1), false, false); const unsigned t0 = t[0], t1 = t[1]; r = __builtin_bit_cast(float, t0) + __builtin_bit_cast(float, t1); }
    r += dpp_f<0x128>(r); r += dpp_f<0x124>(r); r += dpp_f<0x122>(r); r += dpp_f<0x121>(r);
    return r;
}
__device__ __forceinline__ void peer_compute8(const PeerBuf8& B, const unsigned (&xw)[8], float xs, float gs0, float gs1, float su0, float su1, int hh, int lane, float (&acc)[16]) {
    float pa[4], pb[4];
#pragma unroll
    for (int j = 0; j < 8; ++j) { float s0 = 0.f, s1 = 0.f;
#pragma unroll
        for (int dw = 0; dw < 2; ++dw) {
            s0 = __builtin_amdgcn_fdot2_f32_bf16(__builtin_amdgcn_cvt_scalef32_pk_bf16_fp4(B.u[j][dw], 1.0f, 0), __builtin_bit_cast(bf16x2_t, xw[4 * dw + 0]), s0, false);
            s1 = __builtin_amdgcn_fdot2_f32_bf16(__builtin_amdgcn_cvt_scalef32_pk_bf16_fp4(B.u[j][dw], 1.0f, 1), __builtin_bit_cast(bf16x2_t, xw[4 * dw + 1]), s1, false);
            s0 = __builtin_amdgcn_fdot2_f32_bf16(__builtin_amdgcn_cvt_scalef32_pk_bf16_fp4(B.u[j][dw], 1.0f, 2), __builtin_bit_cast(bf16x2_t, xw[4 * dw + 2]), s0, false);
            s1 = __builtin_amdgcn_fdot2_f32_bf16(__builtin_amdgcn_cvt_scalef32_pk_bf16_fp4(B.u[j][dw], 1.0f, 3), __builtin_bit_cast(bf16x2_t, xw[4 * dw + 3]), s1, false); }
        if (j < 4) pa[j] = s0 + s1; else pb[j - 4] = s0 + s1; }
    const float ra = quad_reduce(pa), rb = quad_reduce(pb);
    const int row = lane >> 4, jj = ((row & 1) << 1) | (row >> 1), hi = (lane >> 3) & 1;
    const int k = hh * 8 + 4 * hi + jj;
    const float r = (hi ? rb : ra) * xs;
    const float gsel = __shfl(k < 64 ? gs0 : gs1, k & 63);
    const float su = __shfl(k < 64 ? su0 : su1, k & 63);
    const int coef = __builtin_bit_cast(int, gsel * gelu_as(r * su));
    const float c[8] = { __builtin_bit_cast(float, __builtin_amdgcn_readlane(coef, 0)), __builtin_bit_cast(float, __builtin_amdgcn_readlane(coef, 32)), __builtin_bit_cast(float, __builtin_amdgcn_readlane(coef, 16)), __builtin_bit_cast(float, __builtin_amdgcn_readlane(coef, 48)),
                         __builtin_bit_cast(float, __builtin_amdgcn_readlane(coef, 8)), __builtin_bit_cast(float, __builtin_amdgcn_readlane(coef, 40)), __builtin_bit_cast(float, __builtin_amdgcn_readlane(coef, 24)), __builtin_bit_cast(float, __builtin_amdgcn_readlane(coef, 56)) };
#pragma unroll
    for (int j = 0; j < 8; ++j) { float f[16]; dec4(B.v[j], f);
#pragma unroll
        for (int i = 0; i < 16; ++i) acc[i] += c[j] * f[i]; }
}
__device__ __forceinline__ int tok_fetch(unsigned* qhead, int lane) {
    unsigned v = 0u;
    if (lane == 0) v = __hip_atomic_fetch_add(qhead, 1u, __ATOMIC_RELAXED, __HIP_MEMORY_SCOPE_AGENT);
    return (int)__builtin_amdgcn_readfirstlane(v);
}
__device__ __forceinline__ void p_peer_apply4(const bf16* HN2, const int* IDX, const float* GATE, const PeerTabs Tb, const float* SS2, const float* gffn, const float* gfin, float* HOUT, unsigned* qhead, int lane) {
    PeerBuf8 A, Bq;
    const int xq = (int)(blockIdx.x & 7u); qhead += 64 * xq;
    auto TOKID = [xq](int q_) { return q_ < (T / 8) ? xq + 8 * q_ : T; };
    int t = TOKID(tok_fetch(qhead, lane)), t1 = TOKID(tok_fetch(qhead, lane));
    int i0 = 0, i1 = 0;
    float su0 = 0.f, su1 = 0.f, sv0 = 0.f, sv1 = 0.f;
    if (t < T) { i0 = IDX[(size_t)t * 128 + lane]; i1 = IDX[(size_t)t * 128 + 64 + lane]; su0 = Tb.SU[i0]; su1 = Tb.SU[i1]; sv0 = Tb.SV[i0]; sv1 = Tb.SV[i1]; peer_load8(A, Tb, i0, i1, 0, lane); }
    while (t < T) {
        const int t2 = TOKID(tok_fetch(qhead, lane));
        v2u hw[4];
        const float xs = 1.0f / sqrtf(SS2[t] * (1.0f / DM) + EPS);
#pragma unroll
        for (int j = 0; j < 4; ++j) hw[j] = *(const v2u*)(HN2 + (size_t)t * DM + 256 * j + 4 * lane);
        const unsigned xw[8] = {hw[0].x, hw[0].y, hw[1].x, hw[1].y, hw[2].x, hw[2].y, hw[3].x, hw[3].y};
        const float gs0 = GATE[(size_t)t * 128 + lane] * sv0, gs1 = GATE[(size_t)t * 128 + 64 + lane] * sv1;
        const int tn = t1 < T ? t1 : t;
        const int n0 = IDX[(size_t)tn * 128 + lane], n1 = IDX[(size_t)tn * 128 + 64 + lane];
        float acc[16];
#pragma unroll
        for (int i = 0; i < 16; ++i) acc[i] = 0.f;
        float nu0 = 0.f, nu1 = 0.f, nv0 = 0.f, nv1 = 0.f;
        for (int hh = 0; hh < 16; hh += 2) {
            peer_load8(Bq, Tb, i0, i1, hh + 1, lane);
            peer_compute8(A, xw, xs, gs0, gs1, su0, su1, hh, lane, acc);
            if (hh == 2) { nu0 = Tb.SU[n0]; nu1 = Tb.SU[n1]; nv0 = Tb.SV[n0]; nv1 = Tb.SV[n1]; }
            if (hh + 2 < 16) peer_load8(A, Tb, i0, i1, hh + 2, lane); else peer_load8(A, Tb, n0, n1, 0, lane);
            peer_compute8(Bq, xw, xs, gs0, gs1, su0, su1, hh + 1, lane, acc);
        }
        i0 = n0; i1 = n1; su0 = nu0; su1 = nu1; sv0 = nv0; sv1 = nv1;
        float* hp = HOUT + (size_t)t * DM + 4 * lane;
        f32x4 y[4]; float ss = 0.f;
#pragma unroll
        for (int j = 0; j < 4; ++j) { const f32x4 gf = *(const f32x4*)(gffn + 256 * j + 4 * lane);
            const f32x4 hv = (f32x4){bfl(hw[j].x) * __builtin_amdgcn_rcpf(gf.x), bfh(hw[j].x) * __builtin_amdgcn_rcpf(gf.y), bfl(hw[j].y) * __builtin_amdgcn_rcpf(gf.z), bfh(hw[j].y) * __builtin_amdgcn_rcpf(gf.w)};
            y[j] = hv + (f32x4){acc[4 * j], acc[4 * j + 1], acc[4 * j + 2], acc[4 * j + 3]}; ss += (y[j].x * y[j].x + y[j].y * y[j].y) + (y[j].z * y[j].z + y[j].w * y[j].w); }
        const float rstd = 1.0f / sqrtf(wave_sum(ss) * (1.0f / DM) + EPS);
        const float* gp = gfin + 4 * lane;
#pragma unroll
        for (int j = 0; j < 4; ++j) *(f32x4*)(hp + 256 * j) = y[j] * rstd * *(const f32x4*)(gp + 256 * j);
        t = t1; t1 = t2;
    }
}

typedef short s16x4 __attribute__((ext_vector_type(4)));
typedef short v4i16_t __attribute__((ext_vector_type(4)));
__device__ __forceinline__ s16x4 lds_tr16(LAS unsigned char* p) { return __builtin_bit_cast(s16x4, __builtin_amdgcn_ds_read_tr16_b64_v4i16((LAS v4i16_t*)p)); }
__device__ __forceinline__ bf16x8 cat8(s16x4 a, s16x4 b) { return (bf16x8){a[0], a[1], a[2], a[3], b[0], b[1], b[2], b[3]}; }
constexpr int RP_QK = 144, RP_V = 288;
struct QkRegs { v4u a, b; };
struct CsRegs { f32x4 c0, c1, s0, s1; };
struct VRegs { v4u a, b, c, d; };
__device__ __forceinline__ void qk_issue(QkRegs& R, const bf16* src, int tid) { const int j = tid >> 2, part = tid & 3; const bf16* rp = src + (size_t)j * 512; R.a = *(const v4u*)(rp + 8 * part); R.b = *(const v4u*)(rp + 32 + 8 * part); }
__device__ __forceinline__ void cs_issue(CsRegs& R, int pos0, const float* cosR, const float* sinR, int tid) { const int j = tid >> 2, part = tid & 3;
    const float* cp = cosR + (size_t)(pos0 + j) * 32 + 8 * part; const float* sp = sinR + (size_t)(pos0 + j) * 32 + 8 * part;
    R.c0 = *(const f32x4*)cp; R.c1 = *(const f32x4*)(cp + 4); R.s0 = *(const f32x4*)sp; R.s1 = *(const f32x4*)(sp + 4); }
__device__ __forceinline__ void v_issue(VRegs& R, const bf16* src, int tid) { const int j = tid >> 2, part = tid & 3; const v4u* rp = (const v4u*)(src + (size_t)j * 1024 + 32 * part); R.a = rp[0]; R.b = rp[1]; R.c = rp[2]; R.d = rp[3]; }
__device__ __forceinline__ void qk_finish(LAS unsigned char* dst, const QkRegs& R, const CsRegs& C, float base, float lg2, int wmode, int tid) {
    const int j = tid >> 2, part = tid & 3;
    const v4u a = R.a, b = R.b;
    const float sc = wmode ? base * __builtin_amdgcn_exp2f(lg2 * (float)(127 - j)) : base;
    const float x1[8] = {bfl(a.x), bfh(a.x), bfl(a.y), bfh(a.y), bfl(a.z), bfh(a.z), bfl(a.w), bfh(a.w)};
    const float x2[8] = {bfl(b.x), bfh(b.x), bfl(b.y), bfh(b.y), bfl(b.z), bfh(b.z), bfl(b.w), bfh(b.w)};
    const float cc[8] = {C.c0.x, C.c0.y, C.c0.z, C.c0.w, C.c1.x, C.c1.y, C.c1.z, C.c1.w}, ss[8] = {C.s0.x, C.s0.y, C.s0.z, C.s0.w, C.s1.x, C.s1.y, C.s1.z, C.s1.w};
    float o1[8], o2[8];
#pragma unroll
    for (int e = 0; e < 8; ++e) { o1[e] = (x1[e] * cc[e] - x2[e] * ss[e]) * sc; o2[e] = (x2[e] * cc[e] + x1[e] * ss[e]) * sc; }
    v4u w1, w2; w1.x = pk2(o1[0], o1[1]); w1.y = pk2(o1[2], o1[3]); w1.z = pk2(o1[4], o1[5]); w1.w = pk2(o1[6], o1[7]);
    w2.x = pk2(o2[0], o2[1]); w2.y = pk2(o2[2], o2[3]); w2.z = pk2(o2[4], o2[5]); w2.w = pk2(o2[6], o2[7]);
    *(LAS v4u*)(dst + j * RP_QK + 16 * part) = w1; *(LAS v4u*)(dst + j * RP_QK + 64 + 16 * part) = w2;
}
__device__ __forceinline__ void v_finish(LAS unsigned char* dst, const VRegs& R, int tid) { const int j = tid >> 2, part = tid & 3; LAS v4u* dp = (LAS v4u*)(dst + j * RP_V + 64 * part); dp[0] = R.a; dp[1] = R.b; dp[2] = R.c; dp[3] = R.d; }
__device__ __forceinline__ void p_ret_kv(LAS unsigned char* lds, const bf16* KR, const bf16* VR, const float* tab, bf16* KVT, int bid, int G, int wave, int lane) {
    LAS unsigned char* Ks = lds; LAS unsigned char* Vs = lds + 128 * RP_QK;
    const float* cosR = tab + 2048 * 16, *sinR = tab + 2048 * 16 + 2048 * 32;
    const int tid = threadIdx.x, c = lane & 15, g = lane >> 4, q = c >> 2, p = c & 3;
    QkRegs kq; CsRegs cs; VRegs vv;
    if (bid < 1024) { const int b = bid & 7, n = (bid >> 3) & 15, h = bid >> 7; const size_t row0 = (size_t)b * SEQ + n * 128;
        qk_issue(kq, KR + row0 * 512 + h * 64, tid); cs_issue(cs, n * 128, cosR, sinR, tid); v_issue(vv, VR + row0 * 1024 + h * 128, tid); }
    for (int u = bid; u < 1024; u += G) {
        const int b = u & 7, n = (u >> 3) & 15, h = u >> 7;
        const float lg2 = log2f(1.0f - exp2f(-5.0f - (float)h));
        __syncthreads();
        qk_finish(Ks, kq, cs, 0.125f, lg2, 1, tid);
        v_finish(Vs, vv, tid);
        __syncthreads();
        { const int u2 = u + G; if (u2 < 1024) { const int b2 = u2 & 7, n2 = (u2 >> 3) & 15, h2 = u2 >> 7; const size_t r2 = (size_t)b2 * SEQ + n2 * 128;
            qk_issue(kq, KR + r2 * 512 + h2 * 64, tid); cs_issue(cs, n2 * 128, cosR, sinR, tid); v_issue(vv, VR + r2 * 1024 + h2 * 128, tid); } }
        const int e0 = 16 * wave;
        f32x4 acc[4];
#pragma unroll
        for (int dt = 0; dt < 4; ++dt) acc[dt] = (f32x4){0.f, 0.f, 0.f, 0.f};
#pragma unroll
        for (int ks = 0; ks < 4; ++ks) {
            const int key0 = 32 * ks + 4 * g + q;
            const bf16x8 a = cat8(lds_tr16(Vs + key0 * RP_V + (e0 + 4 * p) * 2), lds_tr16(Vs + (key0 + 16) * RP_V + (e0 + 4 * p) * 2));
#pragma unroll
            for (int dt = 0; dt < 4; ++dt) {
                const bf16x8 bb = cat8(lds_tr16(Ks + key0 * RP_QK + (16 * dt + 4 * p) * 2), lds_tr16(Ks + (key0 + 16) * RP_QK + (16 * dt + 4 * p) * 2));
                acc[dt] = __builtin_amdgcn_mfma_f32_16x16x32_bf16(a, bb, acc[dt], 0, 0, 0);
            }
        }
        bf16* op = KVT + (size_t)((b * 8 + h) * 16 + n) * 8192;
#pragma unroll
        for (int dt = 0; dt < 4; ++dt)
#pragma unroll
            for (int r = 0; r < 4; ++r) op[(e0 + 4 * g + r) * 64 + 16 * dt + c] = (bf16)f2bf(acc[dt][r]);
    }
    __syncthreads();
}
__device__ __forceinline__ void p_ret_out(LAS unsigned char* lds, const bf16* QR, const bf16* KR, const bf16* VRIN, bf16* RETOUT, const bf16* GR, const float* tab, const bf16* KVT, int bid, int G, int wave, int lane) {
    LAS unsigned char* Qs = lds; LAS unsigned char* Ks = lds + 128 * RP_QK; LAS unsigned char* STs = lds + 2 * 128 * RP_QK; LAS unsigned char* Vs = lds + 3 * 128 * RP_QK;
    const float* cosR = tab + 2048 * 16, *sinR = tab + 2048 * 16 + 2048 * 32;
    const int tid = threadIdx.x, c = lane & 15, g = lane >> 4, q = c >> 2, p = c & 3;
    for (int item = bid; item < 256; item += G) {
        const int b = item & 7, h = (item >> 5) & 7, n0 = ((item >> 3) & 3) * 4;
        const float lg2 = log2f(1.0f - exp2f(-5.0f - (float)h));
        const float gC = __builtin_amdgcn_exp2f(lg2 * 128.0f);
        const bf16* kvb = KVT + (size_t)((b * 8 + h) * 16) * 8192;
        f32x4 S[4];
#pragma unroll
        for (int k = 0; k < 4; ++k) S[k] = (f32x4){0.f, 0.f, 0.f, 0.f};
        QkRegs qq, kq; CsRegs cs; VRegs vv;
        { const size_t r1 = (size_t)b * SEQ + n0 * 128; qk_issue(qq, QR + r1 * 512 + h * 64, tid); qk_issue(kq, KR + r1 * 512 + h * 64, tid); cs_issue(cs, n0 * 128, cosR, sinR, tid); v_issue(vv, VRIN + r1 * 1024 + h * 128, tid); }
        for (int m = 0; m < n0; m += 4) {
            v2u w[4][4];
#pragma unroll
            for (int mm = 0; mm < 4; ++mm)
#pragma unroll
                for (int k = 0; k < 4; ++k) w[mm][k] = *(const v2u*)(kvb + (size_t)(m + mm) * 8192 + tid * 4 + 2048 * k);
#pragma unroll
            for (int mm = 0; mm < 4; ++mm)
#pragma unroll
                for (int k = 0; k < 4; ++k) S[k] = S[k] * gC + (f32x4){bfl(w[mm][k].x), bfh(w[mm][k].x), bfl(w[mm][k].y), bfh(w[mm][k].y)};
        }
        for (int n = n0; n < n0 + 4; ++n) {
            const size_t row0 = (size_t)b * SEQ + n * 128;
            __syncthreads();
#pragma unroll
            for (int k = 0; k < 4; ++k) { v2u w; w.x = pk2(S[k].x, S[k].y); w.y = pk2(S[k].z, S[k].w); *(LAS v2u*)(STs + ((tid >> 4) + 32 * k) * RP_QK + (tid & 15) * 8) = w; }
            qk_finish(Qs, qq, cs, 1.0f, lg2, 0, tid);
            qk_finish(Ks, kq, cs, 0.125f, lg2, 0, tid);
            v_finish(Vs, vv, tid);
            __syncthreads();
            if (n + 1 < n0 + 4) { const size_t r2 = row0 + 128;
                qk_issue(qq, QR + r2 * 512 + h * 64, tid); qk_issue(kq, KR + r2 * 512 + h * 64, tid); cs_issue(cs, (n + 1) * 128, cosR, sinR, tid); v_issue(vv, VRIN + r2 * 1024 + h * 128, tid); }
            v4u GF[4];
            { const size_t rog = (row0 + 16 * wave + (lane >> 4)) * 1024 + h * 128 + 8 * (lane & 15);
#pragma unroll
              for (int j = 0; j < 4; ++j) GF[j] = *(const v4u*)(GR + rog + (size_t)(4 * j) * 1024); }
            const int i0 = 16 * wave;
            bf16x8 qf[2];
#pragma unroll
            for (int kd = 0; kd < 2; ++kd) qf[kd] = *(const LAS bf16x8*)(Qs + (i0 + c) * RP_QK + (32 * kd + 8 * g) * 2);
            f32x4 acc[8];
#pragma unroll
            for (int et = 0; et < 8; ++et) acc[et] = (f32x4){0.f, 0.f, 0.f, 0.f};
#pragma unroll
            for (int et = 0; et < 8; ++et)
#pragma unroll
                for (int kd = 0; kd < 2; ++kd) {
                    const bf16x8 a = *(const LAS bf16x8*)(STs + (16 * et + c) * RP_QK + (32 * kd + 8 * g) * 2);
                    acc[et] = __builtin_amdgcn_mfma_f32_16x16x32_bf16(a, qf[kd], acc[et], 0, 0, 0);
                }
            { const float wq = __builtin_amdgcn_exp2f(lg2 * (float)(i0 + c + 1));
#pragma unroll
              for (int et = 0; et < 8; ++et) acc[et] = acc[et] * wq; }
            const int nks = (wave >> 1) + 1;
            for (int ks = 0; ks < nks; ++ks) {
                f32x4 p0 = (f32x4){0.f, 0.f, 0.f, 0.f}, p1 = (f32x4){0.f, 0.f, 0.f, 0.f};
#pragma unroll
                for (int kd = 0; kd < 2; ++kd) {
                    const bf16x8 a0 = *(const LAS bf16x8*)(Ks + (32 * ks + c) * RP_QK + (32 * kd + 8 * g) * 2);
                    const bf16x8 a1 = *(const LAS bf16x8*)(Ks + (32 * ks + 16 + c) * RP_QK + (32 * kd + 8 * g) * 2);
                    p0 = __builtin_amdgcn_mfma_f32_16x16x32_bf16(a0, qf[kd], p0, 0, 0, 0);
                    p1 = __builtin_amdgcn_mfma_f32_16x16x32_bf16(a1, qf[kd], p1, 0, 0, 0);
                }
                const int i = i0 + c;
                float d0[4], d1[4];
#pragma unroll
                for (int r = 0; r < 4; ++r) {
                    const int dl0 = i - (32 * ks + 4 * g + r), dl1 = dl0 - 16;
                    d0[r] = dl0 >= 0 ? p0[r] * __builtin_amdgcn_exp2f(lg2 * (float)dl0) : 0.f;
                    d1[r] = dl1 >= 0 ? p1[r] * __builtin_amdgcn_exp2f(lg2 * (float)dl1) : 0.f;
                }
                v4u pw; pw.x = pk2(d0[0], d0[1]); pw.y = pk2(d0[2], d0[3]); pw.z = pk2(d1[0], d1[1]); pw.w = pk2(d1[2], d1[3]);
                const bf16x8 pb = __builtin_bit_cast(bf16x8, pw);
                const int key0 = 32 * ks + 4 * g + q;
#pragma unroll
                for (int et = 0; et < 8; ++et) {
                    const bf16x8 a = cat8(lds_tr16(Vs + key0 * RP_V + (16 * et + 4 * p) * 2), lds_tr16(Vs + (key0 + 16) * RP_V + (16 * et + 4 * p) * 2));
                    acc[et] = __builtin_amdgcn_mfma_f32_16x16x32_bf16(a, pb, acc[et], 0, 0, 0);
                }
            }
            float ssq = 0.f;
#pragma unroll
            for (int et = 0; et < 8; ++et) ssq += (acc[et].x * acc[et].x + acc[et].y * acc[et].y) + (acc[et].z * acc[et].z + acc[et].w * acc[et].w);
            ssq += __shfl_xor(ssq, 16); ssq += __shfl_xor(ssq, 32);
            const float rs = 1.0f / sqrtf(ssq * (1.0f / 128.0f) + EPS);
            { LAS unsigned char* ost = lds + 3 * 128 * RP_QK + 128 * RP_V + wave * (16 * 272);
#pragma unroll
              for (int et = 0; et < 8; ++et) { v2u o; o.x = pk2(acc[et].x * rs, acc[et].y * rs); o.y = pk2(acc[et].z * rs, acc[et].w * rs); *(LAS v2u*)(ost + c * 272 + (16 * et + 4 * g) * 2) = o; }
              asm volatile("s_waitcnt lgkmcnt(0)" ::: "memory");
              const size_t ro = (row0 + i0 + (lane >> 4)) * 1024 + h * 128 + 8 * (lane & 15);
#pragma unroll
              for (int j = 0; j < 4; ++j) {
                  const v4u ov = *(const LAS v4u*)(ost + (4 * j + (lane >> 4)) * 272 + 16 * (lane & 15));
                  const unsigned ow[4] = {ov.x, ov.y, ov.z, ov.w}, gw4[4] = {GF[j].x, GF[j].y, GF[j].z, GF[j].w};
                  float rv[8];
#pragma unroll
                  for (int i = 0; i < 4; ++i) { const float g0 = bfl(gw4[i]), g1 = bfh(gw4[i]); rv[2 * i] = g0 / (1.f + __expf(-g0)) * bfl(ow[i]) * 16.f; rv[2 * i + 1] = g1 / (1.f + __expf(-g1)) * bfh(ow[i]) * 16.f; }
                  int q0 = __builtin_amdgcn_cvt_pk_fp8_f32(rv[0], rv[1], 0, false); q0 = __builtin_amdgcn_cvt_pk_fp8_f32(rv[2], rv[3], q0, true);
                  int q1 = __builtin_amdgcn_cvt_pk_fp8_f32(rv[4], rv[5], 0, false); q1 = __builtin_amdgcn_cvt_pk_fp8_f32(rv[6], rv[7], q1, true);
                  *(v2u*)((unsigned char*)RETOUT + ro + (size_t)(4 * j) * 1024) = (v2u){(unsigned)q0, (unsigned)q1};
              }
              asm volatile("s_waitcnt lgkmcnt(0)" ::: "memory"); }
            if (n < n0 + 3) {
#pragma unroll
                for (int k = 0; k < 4; ++k) { const v2u w = *(const v2u*)(kvb + (size_t)n * 8192 + tid * 4 + 2048 * k); S[k] = S[k] * gC + (f32x4){bfl(w.x), bfh(w.x), bfl(w.y), bfh(w.y)}; }
            }
        }
    }
    __syncthreads();
}
constexpr int RP_A = 144;
__device__ __forceinline__ void p_attn(LAS unsigned char* lds, const bf16* QA, const bf16* KVA, const float* tab, const float* sinks, bf16* ATT, int bid, int G, int wave, int lane) {
    LAS unsigned char* Ks = lds; LAS unsigned char* Vs = lds + 272 * RP_A;
    const float* cosA = tab, *sinA = tab + 2048 * 8;
    const int tid = threadIdx.x, c = lane & 15, g = lane >> 4, q = c >> 2, p = c & 3;
    constexpr float QS = 0.125f * 1.4426950408889634f;
    for (int u = bid; u < 256; u += G) {
        const int b = u & 7, kvh = (u >> 3) & 1, nb = u >> 4;
        __syncthreads();
        { const int row = tid >> 1, half = tid & 1, pos = nb * 128 - 128 + row;
          v4u k0 = (v4u){0u, 0u, 0u, 0u}, k1 = k0, k2 = k0, k3 = k0, v0 = k0, v1 = k0, v2 = k0, v3 = k0;
          if (pos >= 0) {
              const v4u* kp = (const v4u*)(KVA + (size_t)(b * SEQ + pos) * 256 + kvh * 64 + 32 * half); const v4u* vp = kp + 16;
              k0 = kp[0]; k1 = kp[1]; k2 = kp[2]; k3 = kp[3]; v0 = vp[0]; v1 = vp[1]; v2 = vp[2]; v3 = vp[3];
              if (half == 0) {
                  const f32x4 c0 = *(const f32x4*)(cosA + pos * 8), c1 = *(const f32x4*)(cosA + pos * 8 + 4), s0 = *(const f32x4*)(sinA + pos * 8), s1 = *(const f32x4*)(sinA + pos * 8 + 4);
                  const float x1[8] = {bfl(k0.x), bfh(k0.x), bfl(k0.y), bfh(k0.y), bfl(k0.z), bfh(k0.z), bfl(k0.w), bfh(k0.w)};
                  const float x2[8] = {bfl(k1.x), bfh(k1.x), bfl(k1.y), bfh(k1.y), bfl(k1.z), bfh(k1.z), bfl(k1.w), bfh(k1.w)};
                  const float cc[8] = {c0.x, c0.y, c0.z, c0.w, c1.x, c1.y, c1.z, c1.w}, ss[8] = {s0.x, s0.y, s0.z, s0.w, s1.x, s1.y, s1.z, s1.w};
                  float o1[8], o2[8];
#pragma unroll
                  for (int e = 0; e < 8; ++e) { o1[e] = x1[e] * cc[e] - x2[e] * ss[e]; o2[e] = x2[e] * cc[e] + x1[e] * ss[e]; }
                  k0.x = pk2(o1[0], o1[1]); k0.y = pk2(o1[2], o1[3]); k0.z = pk2(o1[4], o1[5]); k0.w = pk2(o1[6], o1[7]);
                  k1.x = pk2(o2[0], o2[1]); k1.y = pk2(o2[2], o2[3]); k1.z = pk2(o2[4], o2[5]); k1.w = pk2(o2[6], o2[7]);
              }
          }
          LAS v4u* kd = (LAS v4u*)(Ks + row * RP_A + 64 * half); LAS v4u* vd = (LAS v4u*)(Vs + row * RP_A + 64 * half);
          kd[0] = k0; kd[1] = k1; kd[2] = k2; kd[3] = k3; vd[0] = v0; vd[1] = v1; vd[2] = v2; vd[3] = v3;
          if (tid < 128) { const int pr = 256 + (tid >> 3), ch = tid & 7; *(LAS v4u*)(Ks + pr * RP_A + 16 * ch) = (v4u){0u, 0u, 0u, 0u}; *(LAS v4u*)(Vs + pr * RP_A + 16 * ch) = (v4u){0u, 0u, 0u, 0u}; }
        }
        __syncthreads();
        const int hq = kvh * 4 + (wave >> 1), qh = wave & 1;
        const float sink2 = sinks[hq] * 1.4426950408889634f;
        for (int it = 0; it < 4; ++it) {
            const int il0 = 64 * qh + 16 * it, base = il0;
            const int tq = nb * 128 + il0 + c;
            const size_t qrow = (size_t)b * SEQ + tq;
            v4u qa = *(const v4u*)(QA + qrow * 512 + hq * 64 + 8 * g), qb = *(const v4u*)(QA + qrow * 512 + hq * 64 + 32 + 8 * g);
            { v4u pa; pa.x = __shfl_xor(qa.x, 16); pa.y = __shfl_xor(qa.y, 16); pa.z = __shfl_xor(qa.z, 16); pa.w = __shfl_xor(qa.w, 16);
              const f32x4 c0 = *(const f32x4*)(cosA + tq * 8), c1 = *(const f32x4*)(cosA + tq * 8 + 4), s0 = *(const f32x4*)(sinA + tq * 8), s1 = *(const f32x4*)(sinA + tq * 8 + 4);
              const float mine[8] = {bfl(qa.x), bfh(qa.x), bfl(qa.y), bfh(qa.y), bfl(qa.z), bfh(qa.z), bfl(qa.w), bfh(qa.w)};
              const float oth[8] = {bfl(pa.x), bfh(pa.x), bfl(pa.y), bfh(pa.y), bfl(pa.z), bfh(pa.z), bfl(pa.w), bfh(pa.w)};
              const float cc[8] = {c0.x, c0.y, c0.z, c0.w, c1.x, c1.y, c1.z, c1.w}, ss[8] = {s0.x, s0.y, s0.z, s0.w, s1.x, s1.y, s1.z, s1.w};
              float o[8];
#pragma unroll
              for (int e = 0; e < 8; ++e) { const float rot = g == 0 ? mine[e] * cc[e] - oth[e] * ss[e] : mine[e] * cc[e] + oth[e] * ss[e]; o[e] = (g < 2 ? rot : mine[e]) * QS; }
              qa.x = pk2(o[0], o[1]); qa.y = pk2(o[2], o[3]); qa.z = pk2(o[4], o[5]); qa.w = pk2(o[6], o[7]);
              qb.x = pk2(bfl(qb.x) * QS, bfh(qb.x) * QS); qb.y = pk2(bfl(qb.y) * QS, bfh(qb.y) * QS); qb.z = pk2(bfl(qb.z) * QS, bfh(qb.z) * QS); qb.w = pk2(bfl(qb.w) * QS, bfh(qb.w) * QS); }
            const bf16x8 qf0 = __builtin_bit_cast(bf16x8, qa), qf1 = __builtin_bit_cast(bf16x8, qb);
            f32x4 s[10];
#pragma unroll
            for (int jt = 0; jt < 10; ++jt) {
                const bf16x8 a0 = *(const LAS bf16x8*)(Ks + (base + 16 * jt + c) * RP_A + (8 * g) * 2);
                const bf16x8 a1 = *(const LAS bf16x8*)(Ks + (base + 16 * jt + c) * RP_A + (32 + 8 * g) * 2);
                s[jt] = __builtin_amdgcn_mfma_f32_16x16x32_bf16(a0, qf0, (f32x4){0.f, 0.f, 0.f, 0.f}, 0, 0, 0);
                s[jt] = __builtin_amdgcn_mfma_f32_16x16x32_bf16(a1, qf1, s[jt], 0, 0, 0);
            }
            const int qi = 128 + il0 + c;
            float m = sink2;
#pragma unroll
            for (int jt = 0; jt < 10; ++jt)
#pragma unroll
                for (int r = 0; r < 4; ++r) {
                    const int kj = base + 16 * jt + 4 * g + r, df = qi - kj;
                    const bool ok = (df >= 0) && (df < 128) && (nb > 0 || kj >= 128);
                    s[jt][r] = ok ? s[jt][r] : -INFINITY;
                    m = fmaxf(m, s[jt][r]);
                }
            m = fmaxf(m, __shfl_xor(m, 16)); m = fmaxf(m, __shfl_xor(m, 32));
            float l = 0.f;
#pragma unroll
            for (int jt = 0; jt < 10; ++jt)
#pragma unroll
                for (int r = 0; r < 4; ++r) { s[jt][r] = __builtin_amdgcn_exp2f(s[jt][r] - m); l += s[jt][r]; }
            l += __shfl_xor(l, 16); l += __shfl_xor(l, 32);
            l += __builtin_amdgcn_exp2f(sink2 - m);
            f32x4 acc[4];
#pragma unroll
            for (int dt = 0; dt < 4; ++dt) acc[dt] = (f32x4){0.f, 0.f, 0.f, 0.f};
#pragma unroll
            for (int ks = 0; ks < 5; ++ks) {
                v4u pw; pw.x = pk2(s[2 * ks][0], s[2 * ks][1]); pw.y = pk2(s[2 * ks][2], s[2 * ks][3]); pw.z = pk2(s[2 * ks + 1][0], s[2 * ks + 1][1]); pw.w = pk2(s[2 * ks + 1][2], s[2 * ks + 1][3]);
                const bf16x8 pb = __builtin_bit_cast(bf16x8, pw);
                const int key0 = base + 32 * ks + 4 * g + q;
#pragma unroll
                for (int dt = 0; dt < 4; ++dt) {
                    const bf16x8 a = cat8(lds_tr16(Vs + key0 * RP_A + (16 * dt + 4 * p) * 2), lds_tr16(Vs + (key0 + 16) * RP_A + (16 * dt + 4 * p) * 2));
                    acc[dt] = __builtin_amdgcn_mfma_f32_16x16x32_bf16(a, pb, acc[dt], 0, 0, 0);
                }
            }
            const float rl = 1.0f / l;
            unsigned char* op = (unsigned char*)ATT + qrow * 1024 + hq * 64 + 4 * g;
            const float rl16 = rl * 16.f;
#pragma unroll
            for (int dt = 0; dt < 4; ++dt) { int q = __builtin_amdgcn_cvt_pk_fp8_f32(acc[dt].x * rl16, acc[dt].y * rl16, 0, false); q = __builtin_amdgcn_cvt_pk_fp8_f32(acc[dt].z * rl16, acc[dt].w * rl16, q, true); *(unsigned*)(op + 16 * dt) = (unsigned)q; }
        }
    }
    __syncthreads();
}

constexpr int RP_SK = 272;
constexpr int ROUTE_SCR = 2 * 128 * RP_SK;
#define CE(x, y) do { const int hi_ = max((x), (y)), lo_ = min((x), (y)); (x) = hi_; (y) = lo_; } while (0)
__device__ __forceinline__ int packkey(float f, int idx, unsigned keep) { const int b = __builtin_bit_cast(int, f); const int s = b ^ ((b >> 31) & 0x7fffffff); return (int)(((unsigned)s & keep) | (unsigned)idx); }
__device__ __forceinline__ float keyval(int k, unsigned keep) { const int s = (int)((unsigned)k & keep); return __builtin_bit_cast(float, s ^ ((s >> 31) & 0x7fffffff)); }
__device__ __forceinline__ void sort16(int (&a)[16]) {
    CE(a[0], a[1]); CE(a[3], a[2]); CE(a[4], a[5]); CE(a[7], a[6]); CE(a[8], a[9]); CE(a[11], a[10]);
    CE(a[12], a[13]); CE(a[15], a[14]); CE(a[0], a[2]); CE(a[1], a[3]); CE(a[6], a[4]); CE(a[7], a[5]);
    CE(a[8], a[10]); CE(a[9], a[11]); CE(a[14], a[12]); CE(a[15], a[13]); CE(a[0], a[1]); CE(a[2], a[3]);
    CE(a[5], a[4]); CE(a[7], a[6]); CE(a[8], a[9]); CE(a[10], a[11]); CE(a[13], a[12]); CE(a[15], a[14]);
    CE(a[0], a[4]); CE(a[1], a[5]); CE(a[2], a[6]); CE(a[3], a[7]); CE(a[12], a[8]); CE(a[13], a[9]);
    CE(a[14], a[10]); CE(a[15], a[11]); CE(a[0], a[2]); CE(a[1], a[3]); CE(a[4], a[6]); CE(a[5], a[7]);
    CE(a[10], a[8]); CE(a[11], a[9]); CE(a[14], a[12]); CE(a[15], a[13]); CE(a[0], a[1]); CE(a[2], a[3]);
    CE(a[4], a[5]); CE(a[6], a[7]); CE(a[9], a[8]); CE(a[11], a[10]); CE(a[13], a[12]); CE(a[15], a[14]);
    CE(a[0], a[8]); CE(a[1], a[9]); CE(a[2], a[10]); CE(a[3], a[11]); CE(a[4], a[12]); CE(a[5], a[13]);
    CE(a[6], a[14]); CE(a[7], a[15]); CE(a[0], a[4]); CE(a[1], a[5]); CE(a[2], a[6]); CE(a[3], a[7]);
    CE(a[8], a[12]); CE(a[9], a[13]); CE(a[10], a[14]); CE(a[11], a[15]); CE(a[0], a[2]); CE(a[1], a[3]);
    CE(a[4], a[6]); CE(a[5], a[7]); CE(a[8], a[10]); CE(a[9], a[11]); CE(a[12], a[14]); CE(a[13], a[15]);
    CE(a[0], a[1]); CE(a[2], a[3]); CE(a[4], a[5]); CE(a[6], a[7]); CE(a[8], a[9]); CE(a[10], a[11]);
    CE(a[12], a[13]); CE(a[14], a[15]);
}
__device__ __forceinline__ void merge16(int (&a)[16]) {
    CE(a[0], a[8]); CE(a[1], a[9]); CE(a[2], a[10]); CE(a[3], a[11]); CE(a[4], a[12]); CE(a[5], a[13]);
    CE(a[6], a[14]); CE(a[7], a[15]); CE(a[0], a[4]); CE(a[1], a[5]); CE(a[2], a[6]); CE(a[3], a[7]);
    CE(a[8], a[12]); CE(a[9], a[13]); CE(a[10], a[14]); CE(a[11], a[15]); CE(a[0], a[2]); CE(a[1], a[3]);
    CE(a[4], a[6]); CE(a[5], a[7]); CE(a[8], a[10]); CE(a[9], a[11]); CE(a[12], a[14]); CE(a[13], a[15]);
    CE(a[0], a[1]); CE(a[2], a[3]); CE(a[4], a[5]); CE(a[6], a[7]); CE(a[8], a[9]); CE(a[10], a[11]);
    CE(a[12], a[13]); CE(a[14], a[15]);
}
template <int X> __device__ __forceinline__ void xmerge16(int (&a)[16]) {
    int o[16];
#pragma unroll
    for (int i = 0; i < 16; ++i) o[i] = __shfl_xor(a[15 - i], X);
#pragma unroll
    for (int i = 0; i < 16; ++i) a[i] = max(a[i], o[i]);
    merge16(a);
}
__device__ __forceinline__ void route_half(LAS unsigned char* lds, const bf16* PQ, int p, int t0, int h, int c, int g, int (&ka)[16]) {
    const bf16* qp = PQ + (size_t)(t0 + c) * 2048 + h * 256 + p * 128 + 8 * g;
    bf16x8 qf[4];
#pragma unroll
    for (int ks = 0; ks < 4; ++ks) qf[ks] = *(const bf16x8*)(qp + 32 * ks);
    f32x4 s[8];
#pragma unroll
    for (int kt = 0; kt < 8; ++kt) {
        s[kt] = (f32x4){0.f, 0.f, 0.f, 0.f};
#pragma unroll
        for (int ks = 0; ks < 4; ++ks) {
            const bf16x8 a = *(const LAS bf16x8*)(lds + p * (128 * RP_SK) + (16 * kt + c) * RP_SK + (32 * ks + 8 * g) * 2);
            s[kt] = __builtin_amdgcn_mfma_f32_16x16x32_bf16(a, qf[ks], s[kt], 0, 0, 0);
        }
        if (kt & 1) __builtin_amdgcn_sched_barrier(0);
    }
    int kb[16];
#pragma unroll
    for (int kt = 0; kt < 4; ++kt) {
        ka[4 * kt + 0] = packkey(s[kt].x, (16 * kt + 0) | (g << 2), 0xffffff80); ka[4 * kt + 1] = packkey(s[kt].y, (16 * kt + 1) | (g << 2), 0xffffff80);
        ka[4 * kt + 2] = packkey(s[kt].z, (16 * kt + 2) | (g << 2), 0xffffff80); ka[4 * kt + 3] = packkey(s[kt].w, (16 * kt + 3) | (g << 2), 0xffffff80);
        kb[4 * kt + 0] = packkey(s[kt + 4].x, (16 * (kt + 4) + 0) | (g << 2), 0xffffff80); kb[4 * kt + 1] = packkey(s[kt + 4].y, (16 * (kt + 4) + 1) | (g << 2), 0xffffff80);
        kb[4 * kt + 2] = packkey(s[kt + 4].z, (16 * (kt + 4) + 2) | (g << 2), 0xffffff80); kb[4 * kt + 3] = packkey(s[kt + 4].w, (16 * (kt + 4) + 3) | (g << 2), 0xffffff80);
    }
    sort16(ka); sort16(kb);
#pragma unroll
    for (int i = 0; i < 16; ++i) ka[i] = max(ka[i], kb[15 - i]);
    merge16(ka);
    xmerge16<16>(ka); xmerge16<32>(ka);
}
template <class Sched> __device__ __forceinline__ void p_peer_route2(LAS unsigned char* lds, const bf16* PQ, const bf16* K1b, const bf16* K2b, int* IDX, float* GATE, const Sched& S, int wave, int lane) {
    const int tid = threadIdx.x, c = lane & 15, g = lane >> 4;
    for (int i = tid; i < 4096; i += NTHR) { const int tb = i >> 11, row = (i >> 4) & 127, ch = i & 15;
        *(LAS v4u*)(lds + tb * (128 * RP_SK) + row * RP_SK + ch * 16) = *(const v4u*)((tb ? K2b : K1b) + row * 128 + ch * 8); }
    __syncthreads();
    LAS int* scr = (LAS int*)(lds + ROUTE_SCR + wave * 2048) + c * 32;
    pg8::Unit un;
    for (int ui = 0; S.next(ui, un); ++ui)
    for (int tt = wave; tt < 16; tt += 8) {
        const int h = un.pn, t0 = un.pm * 256 + tt * 16;
        int k1[16], k2[16];
        route_half(lds, PQ, 0, t0, h, c, g, k1);
        route_half(lds, PQ, 1, t0, h, c, g, k2);
        if (g == 0) {
#pragma unroll
            for (int i = 0; i < 16; i += 4) { *(LAS v4u*)(scr + i) = (v4u){(unsigned)k1[i], (unsigned)k1[i + 1], (unsigned)k1[i + 2], (unsigned)k1[i + 3]};
                *(LAS v4u*)(scr + 16 + i) = (v4u){(unsigned)k2[i], (unsigned)k2[i + 1], (unsigned)k2[i + 2], (unsigned)k2[i + 3]}; }
        }
        float f1[16], f2[16];
#pragma unroll
        for (int i = 0; i < 16; ++i) { f1[i] = keyval(k1[i], 0xffffff80); f2[i] = keyval(k2[i], 0xffffff80); }
        int ck[16];
        ck[0] = packkey(g == 0 ? (f1[0] + f2[0]) : g == 1 ? (f1[0] + f2[1]) : g == 2 ? (f1[0] + f2[2]) : (f1[0] + f2[3]), g == 0 ? 0 : g == 1 ? 1 : g == 2 ? 2 : 3, 0xffffff00);
        ck[1] = packkey(g == 0 ? (f1[0] + f2[4]) : g == 1 ? (f1[0] + f2[5]) : g == 2 ? (f1[0] + f2[6]) : (f1[0] + f2[7]), g == 0 ? 4 : g == 1 ? 5 : g == 2 ? 6 : 7, 0xffffff00);
        ck[2] = packkey(g == 0 ? (f1[0] + f2[8]) : g == 1 ? (f1[0] + f2[9]) : g == 2 ? (f1[0] + f2[10]) : (f1[0] + f2[11]), g == 0 ? 8 : g == 1 ? 9 : g == 2 ? 10 : 11, 0xffffff00);
        ck[3] = packkey(g == 0 ? (f1[0] + f2[12]) : g == 1 ? (f1[0] + f2[13]) : g == 2 ? (f1[0] + f2[14]) : (f1[0] + f2[15]), g == 0 ? 12 : g == 1 ? 13 : g == 2 ? 14 : 15, 0xffffff00);
        ck[4] = packkey(g == 0 ? (f1[1] + f2[0]) : g == 1 ? (f1[1] + f2[1]) : g == 2 ? (f1[1] + f2[2]) : (f1[1] + f2[3]), g == 0 ? 16 : g == 1 ? 17 : g == 2 ? 18 : 19, 0xffffff00);
        ck[5] = packkey(g == 0 ? (f1[1] + f2[4]) : g == 1 ? (f1[1] + f2[5]) : g == 2 ? (f1[1] + f2[6]) : (f1[1] + f2[7]), g == 0 ? 20 : g == 1 ? 21 : g == 2 ? 22 : 23, 0xffffff00);
        ck[6] = packkey(g == 0 ? (f1[2] + f2[0]) : g == 1 ? (f1[2] + f2[1]) : g == 2 ? (f1[2] + f2[2]) : (f1[2] + f2[3]), g == 0 ? 32 : g == 1 ? 33 : g == 2 ? 34 : 35, 0xffffff00);
        ck[7] = packkey(g == 0 ? (f1[2] + f2[4]) : g == 1 ? (f1[3] + f2[0]) : g == 2 ? (f1[3] + f2[1]) : (f1[3] + f2[2]), g == 0 ? 36 : g == 1 ? 48 : g == 2 ? 49 : 50, 0xffffff00);
        ck[8] = packkey(g == 0 ? (f1[3] + f2[3]) : g == 1 ? (f1[4] + f2[0]) : g == 2 ? (f1[4] + f2[1]) : (f1[4] + f2[2]), g == 0 ? 51 : g == 1 ? 64 : g == 2 ? 65 : 66, 0xffffff00);
        ck[9] = packkey(g == 0 ? (f1[5] + f2[0]) : g == 1 ? (f1[5] + f2[1]) : g == 2 ? (f1[6] + f2[0]) : (f1[6] + f2[1]), g == 0 ? 80 : g == 1 ? 81 : g == 2 ? 96 : 97, 0xffffff00);
        ck[10] = packkey(g == 0 ? (f1[7] + f2[0]) : g == 1 ? (f1[7] + f2[1]) : g == 2 ? (f1[8] + f2[0]) : (f1[9] + f2[0]), g == 0 ? 112 : g == 1 ? 113 : g == 2 ? 128 : 144, 0xffffff00);
        ck[11] = packkey(g == 0 ? (f1[10] + f2[0]) : g == 1 ? (f1[11] + f2[0]) : g == 2 ? (f1[12] + f2[0]) : (f1[13] + f2[0]), g == 0 ? 160 : g == 1 ? 176 : g == 2 ? 192 : 208, 0xffffff00);
        ck[12] = packkey(g == 0 ? (f1[14] + f2[0]) : g == 1 ? (f1[15] + f2[0]) : g == 2 ? (-3.0e38f) : (-3.0e38f), g == 0 ? 224 : g == 1 ? 240 : g == 2 ? 0 : 0, 0xffffff00);
        ck[13] = (int)0x80000000; ck[14] = (int)0x80000000; ck[15] = (int)0x80000000;
        sort16(ck); xmerge16<16>(ck); xmerge16<32>(ck);
        float den = 0.f; const float tmx = keyval(ck[0], 0xffffff00);
#pragma unroll
        for (int r = 0; r < 16; ++r) den += __expf(keyval(ck[r], 0xffffff00) - tmx);
        const float rden = 1.f / den;
        int mine[4];
#pragma unroll
        for (int j = 0; j < 4; ++j) mine[j] = g == 0 ? ck[j] : g == 1 ? ck[4 + j] : g == 2 ? ck[8 + j] : ck[12 + j];
        asm volatile("s_waitcnt lgkmcnt(0)" ::: "memory");
        v4u eo; f32x4 go;
#pragma unroll
        for (int j = 0; j < 4; ++j) { const int a = (mine[j] >> 4) & 15, b = mine[j] & 15; const int e = ((scr[a] & 127) << 7) | (scr[16 + b] & 127);
            eo[j] = (unsigned)e; go[j] = __expf(keyval(mine[j], 0xffffff00) - tmx) * rden; }
        *(v4u*)(IDX + (size_t)(t0 + c) * 128 + h * 16 + 4 * g) = eo; *(f32x4*)(GATE + (size_t)(t0 + c) * 128 + h * 16 + 4 * g) = go;
        asm volatile("s_waitcnt lgkmcnt(0)" ::: "memory");
    }
    __syncthreads();
}
#undef CE
__global__ void __launch_bounds__(NTHR, 2) mk_fwd(Args args) {
    extern __shared__ __attribute__((aligned(16))) unsigned char lds_raw[];
    LAS unsigned char* lds = (LAS unsigned char*)lds_raw;
    volatile LAS unsigned* MISC = (volatile LAS unsigned*)(lds + MISC_OFF);
    const int tid = threadIdx.x, lane = tid & 63, wave = __builtin_amdgcn_readfirstlane(tid >> 6);
    const int G = gridDim.x, bid = blockIdx.x;
    const int gtid = bid * NTHR + tid, gthreads = G * NTHR, gw = bid * NWAVES + wave, NGW = G * NWAVES;
    unsigned char* ws = args.ws; unsigned char* dob = (unsigned char*)args.out;
    gu32* ctl = (gu32*)(ws + WS_CTL);
    const float* x = args.in[0]; const float* norm_mix = args.in[1]; const float* w_in = args.in[2]; const float* sinks = args.in[3];
    const float* w_att = args.in[4]; const float* w_ret = args.in[5]; const float* w_out = args.in[6]; const float* norm_ffn = args.in[7];
    const float* wq = args.in[8]; const float* k1 = args.in[9]; const float* k2 = args.in[10]; const float* pu = args.in[11]; const float* pv = args.in[12];
    const float* norm_final = args.in[13];
    float* tab = (float*)(ws + WS_TAB);
    for (int u = tid; u < (LDS_BYTES - LDSCTL_OFF) / 4; u += NTHR) ((LAS unsigned*)(lds + LDSCTL_OFF))[u] = 0u;
    __syncthreads();
    const bool multi = (args.ph_hi - args.ph_lo) > 1;
    XcdBarrier bar; bar.bar = (unsigned*)(ctl + CW_BAR); bar.x = 0; bar.st = nullptr;
    if (multi) bar = xcd_barrier_post((unsigned*)(ctl + CW_BAR), MISC + 8);
    const int lo = args.ph_lo, hi = args.ph_hi;
#define IN(k) (lo <= (k) && (k) < hi)
#define SEAM(k) do { if (IN(k) && IN((k) + 1)) xcd_barrier(bar); } while (0)

    constexpr int I_IN = (DM / 64) * (INW / 32), I_A = (512 / 64) * (DM / 32), I_R = (DM / 64) * (DM / 32), I_O = I_R, I_Q = (DM / 64) * (2048 / 32);
    constexpr int NUNITS8 = (T / 256) * (INW / 256), TAB_LATE = 0;
    if (IN(0)) {
        p_tables(tab, gtid, gthreads);
        for (int i = gtid; i < T; i += gthreads) ((float*)(ws + WS_SS2))[i] = 0.f;
        p0_win_i8(w_in, ws + WS_WIN8, (float*)(ws + WS_CSC), (LAS float*)(lds + RING_OFF), bid, G);
        LAS float* scr = (LAS float*)(lds + RING_OFF + wave * 16384);
        for (int m = gw; m < T; m += NGW) rms_row_to_bf16(x + (size_t)m * DM, norm_mix, (bf16*)(dob + DO_HN) + (size_t)m * DM, (unsigned*)(ws + WS_HN8 + (size_t)m * DM), (float*)(ws + WS_RSC) + m, lane);
        for (int i = gtid; i < 2 * 128 * 128 / 4; i += gthreads) {
            const int tb = i >> 12, o = (i & 4095) * 4; const f32x4 v = *(const f32x4*)((tb ? k2 : k1) + o);
            *(unsigned long long*)((bf16*)(ws + (tb ? WS_K2 : WS_K1)) + o) = (unsigned long long)pk2(v.x, v.y) | ((unsigned long long)pk2(v.z, v.w) << 32); }
    }
    SEAM(0);
    if (IN(1)) {
        const int NG8 = G >> 3, NTX = ((G & 7) == 0 && NG8 >= 16) ? 5 : 0, xg = bid >> 3, xq = bid & 7;
        const bool tabwg = NTX > 0 && xg >= NG8 - NTX;
        const int GG = NTX > 0 ? (NG8 - NTX) * 8 : G, cidx = NTX > 0 ? xg * 8 + xq : bid;
        if (!tabwg) {
            { pg8::Gemm8 g{ws + WS_HN8, ws + WS_WIN8, T, INW, DM}; pg8::StaticOrder S; S.init(T, INW, GG, cidx);
              pg8::EpiProjI8 E{ws, dob + DO_GT, (const float*)(ws + WS_RSC), (const float*)(ws + WS_CSC)};
              pg8::gemm_phase_i8<pg8::EpiProjI8, pg8::StaticOrder>(lds + RING_OFF, g, S, E); }
            const int rem = NUNITS8 % GG; const bool share = rem == 0 || cidx >= rem; const int nshare = rem == 0 ? GG : GG - rem, myi = rem == 0 ? cidx : cidx - rem;
            if (share) {
                LAS float* scr = (LAS float*)(lds + RING_OFF + wave * 16384);
                const int gw2 = myi * NWAVES + wave, NGW2 = nshare * NWAVES;
                for (int it = gw2; it < I_A + I_R + I_O + I_Q; it += NGW2) {
                    int r = it;
                    if (r < I_A) { p0_transpose_item(w_att, 512, DM, nullptr, scr, r, lane, 1024, ws + WS_WA); continue; } r -= I_A;
                    if (r < I_R) { p0_transpose_item(w_ret, DM, DM, nullptr, scr, r, lane, 0, ws + WS_WR); continue; } r -= I_R;
                    if (r < I_O) { p0_transpose_item(w_out, DM, DM, nullptr, scr, r, lane, 0, ws + WS_WO); continue; } r -= I_O;
                    p0_transpose_item(wq, DM, 2048, (bf16*)(ws + WS_WQ), scr, r, lane);
                }
            }
        }
        if (tabwg || NTX == 0) {
            const int ti = NTX > 0 ? (xg - (NG8 - NTX)) * 8 + xq : bid, NGW2 = (NTX > 0 ? NTX * 8 : G) * NWAVES, gw2 = ti * NWAVES + wave;
            for (int m0 = gw2; m0 < 2 * 16384; m0 += 4 * NGW2) {
                const float* xr[4]; unsigned char* o4[4]; float* sc[4];
#pragma unroll
                for (int r = 0; r < 4; ++r) { int m = m0 + r * NGW2; m = m < 2 * 16384 ? m : m0;
                    const int e = m & 16383; const bool isv = m >= 16384;
                    xr[r] = (isv ? pv : pu) + (size_t)e * DM; o4[r] = ws + WS_U4 + (size_t)e * 1024 + (isv ? 512 : 0); sc[r] = (float*)(ws + (isv ? WS_SV : WS_SU)) + e; }
                rows_to_fp4<4>(xr, o4, sc, lane);
            }
        }
    }
    SEAM(1);
    if (IN(2)) {
        p_attn(lds + RING_OFF, (const bf16*)(ws + WS_QA), (const bf16*)(ws + WS_KVA), tab, sinks, (bf16*)(ws + WS_ATT), bid, G, wave, lane);
        p_ret_kv(lds + RING_OFF, (const bf16*)(ws + WS_KR), (const bf16*)(ws + WS_VR), tab, (bf16*)(dob + DO_KVT), bid, G, wave, lane);
    }
    SEAM(2);
    if (IN(3)) {
        p_ret_out(lds + RING_OFF, (const bf16*)(ws + WS_QR), (const bf16*)(ws + WS_KR), (const bf16*)(ws + WS_VR), (bf16*)(ws + WS_RET), (const bf16*)(ws + WS_GR), tab, (const bf16*)(dob + DO_KVT), bid, G, wave, lane);
    }
    SEAM(3);
    if (IN(4)) {
        pg8::Gemm2F8 g{ws + WS_ATT, ws + WS_WA, 512, ws + WS_RET, ws + WS_WR, DM, DM, T, DM};
        pg8::StaticOrder S; S.init(T, DM, G, bid);
        pg8::EpiMerge2 E{ws + WS_GA, dob + DO_GT, ws + WS_MERGED, 16.0f / 8192.0f};
        pg8::gemm_phase2_f8<pg8::EpiMerge2>(lds + RING_OFF, g, S, E);
    }
    SEAM(5);
    if (IN(6)) {
        pg8::Gemm8 g{ws + WS_MERGED, ws + WS_WO, T, DM, DM}; pg8::StaticOrder S; S.init(T, DM, G, bid);
        pg8::EpiResid2F8 E{x, args.out, (pg8::bf16_t*)(ws + WS_HN2), norm_ffn, (float*)(ws + WS_SS2)};
        pg8::gemm_phase_f8<pg8::EpiResid2F8, pg8::StaticOrder>(lds + RING_OFF, g, S, E);
    }
    SEAM(6);
    if (IN(7)) {
        pg8::Gemm g{(const pg8::bf16_t*)(ws + WS_HN2), (const pg8::bf16_t*)(ws + WS_WQ), T, 2048, DM}; pg8::StaticOrder S; S.init(T, 2048, G, bid);
        pg8::EpiRowScale E{(pg8::bf16_t*)(ws + WS_PQ), 2048, (const float*)(ws + WS_SS2)};
        pg8::gemm_phase<pg8::EpiRowScale, pg8::StaticOrder, true, true>(lds + RING_OFF, g, S, E);
        asm volatile("s_waitcnt vmcnt(0)" ::: "memory"); __syncthreads();
        p_peer_route2(lds + RING_OFF, (const bf16*)(ws + WS_PQ), (const bf16*)(ws + WS_K1), (const bf16*)(ws + WS_K2), (int*)(ws + WS_IDX), (float*)(ws + WS_GATE), S, wave, lane);
    }
    SEAM(7);
    if (IN(8)) {
        const PeerTabs Tb{ws + WS_U4, ws + WS_V4, (const float*)(ws + WS_SU), (const float*)(ws + WS_SV)};
        p_peer_apply4((const bf16*)(ws + WS_HN2), (const int*)(ws + WS_IDX), (const float*)(ws + WS_GATE), Tb, (const float*)(ws + WS_SS2), norm_ffn, norm_final, args.out, (unsigned*)(ctl + 2048), lane);
    }
#undef IN
#undef SEAM
}

#ifndef MK_PER_PHASE
#define MK_PER_PHASE 0
#endif
constexpr int NPHASE = 9;
extern "C" void kernel_launch(void* const* d_in, const int* in_sizes, int n_in, void* d_out, int out_size, void* d_ws, size_t ws_size, hipStream_t stream) {
    static int grid = 0;
    if (grid == 0) {
        if (n_in != 14 || out_size != T * DM || ws_size < 256 * MiB) { fprintf(stderr, "kernel_launch: unexpected shapes (n_in %d out %d ws %zu)\n", n_in, out_size, ws_size); grid = -1; return; }
        int dev = 0, cus = 0, per_cu = 0;
        if (hipGetDevice(&dev) != hipSuccess || hipDeviceGetAttribute(&cus, hipDeviceAttributeMultiprocessorCount, dev) != hipSuccess) { grid = -1; return; }
        if (hipFuncSetAttribute((const void*)mk_fwd, hipFuncAttributeMaxDynamicSharedMemorySize, LDS_BYTES) != hipSuccess) { fprintf(stderr, "kernel_launch: hipFuncSetAttribute failed\n"); grid = -1; return; }
        if (hipOccupancyMaxActiveBlocksPerMultiprocessor(&per_cu, (const void*)mk_fwd, NTHR, LDS_BYTES) != hipSuccess || per_cu < 1) { fprintf(stderr, "kernel_launch: occupancy query says %d\n", per_cu); per_cu = 1; }
        (void)hipGetLastError();
        grid = cus;
    }
    if (grid < 0) return;
    (void)hipMemsetAsync((char*)d_ws + WS_CTL, 0, CTL_ZERO_BYTES, stream);
    Args a{};
    for (int i = 0; i < 14; ++i) a.in[i] = (const float*)d_in[i];
    a.out = (float*)d_out; a.ws = (unsigned char*)d_ws;
    if (MK_PER_PHASE) {
        for (int p = 0; p < NPHASE; ++p) { a.ph_lo = p; a.ph_hi = p + 1; hipLaunchKernelGGL(mk_fwd, dim3(grid), dim3(NTHR), LDS_BYTES, stream, a); }
    } else {
        a.ph_lo = 0; a.ph_hi = NPHASE;
        hipLaunchKernelGGL(mk_fwd, dim3(grid), dim3(NTHR), LDS_BYTES, stream, a);
    }
}
```
